# Optimizing an MI355X kernel written in HIP

```python
import jax, jax.numpy as jnp
from jax import lax
import numpy as np

D_MODEL = 1024
BATCH = 2
SEQ = 16384
DEPTH = 2

HEAD_DIM = 64
N_MEM_TOKENS = 256
N_MEM_HEADS = 4
MEM_WIDTH = N_MEM_HEADS * HEAD_DIM
MIX_WIDTH = D_MODEL
MIXER_WIDTH = MIX_WIDTH - MEM_WIDTH
CHUNK = 128
GMLP_GROUP_DIM = 128
GMLP_GROUPS = MIXER_WIDTH // GMLP_GROUP_DIM
MOBA_HEADS = MIXER_WIDTH // HEAD_DIM
MOBA_BLOCK = 256
MOBA_TOPK = 3
Q_SUB = 64
D_FF = ((8 * D_MODEL // 3 + 127) // 128) * 128
CONV_WIDTH = 3
N_A_LAYERS = (DEPTH + 1) // 2
N_B_LAYERS = DEPTH // 2
EPS = 1e-6
NEG = -1e30

kernel_name = 'hybrid_gmlp_moba_memxattn_convffn'


def rms_norm(x, g):
    xf = x.astype(jnp.float32)
    y = xf * lax.rsqrt(jnp.mean(xf * xf, axis=-1, keepdims=True) + EPS)
    return (y * g.astype(jnp.float32)).astype(x.dtype)


def mem_cross_attention(q_m, k_m, v_m, g_q):
    B, S, _ = q_m.shape
    q = rms_norm(q_m.reshape(B, S, N_MEM_HEADS, HEAD_DIM), g_q)
    s = jnp.einsum('bshd,bmhd->bhsm', q, k_m).astype(jnp.float32) * (HEAD_DIM ** -0.5)
    p = jax.nn.softmax(s, axis=-1).astype(v_m.dtype)
    o = jnp.einsum('bhsm,bmhd->bshd', p, v_m)
    return o.reshape(B, S, MEM_WIDTH)


def gmlp_spatial_gating(p_mix, g_sgu, w_s, b_s):
    B, S, _ = p_mix.shape
    z = jax.nn.gelu(p_mix)
    u = z[..., :MIXER_WIDTH]
    v = rms_norm(z[..., MIXER_WIDTH:], g_sgu)
    v = v.reshape(B, S // CHUNK, CHUNK, GMLP_GROUPS, GMLP_GROUP_DIM)
    w_causal = w_s * jnp.tril(jnp.ones((CHUNK, CHUNK), w_s.dtype))
    mixed = jnp.einsum('gts,bcsgd->bctgd', w_causal, v) + b_s.T[:, :, None]
    return u * mixed.reshape(B, S, MIXER_WIDTH)


def moba_attention(q, k, v):
    B, H, S, Dh = q.shape
    nb = -(-S // MOBA_BLOCK)
    pad = nb * MOBA_BLOCK - S
    k_blk = jnp.pad(k, ((0, 0), (0, 0), (0, pad), (0, 0))).reshape(B, H, nb, MOBA_BLOCK, Dh)
    v_blk = jnp.pad(v, ((0, 0), (0, 0), (0, pad), (0, 0))).reshape(B, H, nb, MOBA_BLOCK, Dh)
    k_mean = jnp.mean(k_blk.astype(jnp.float32), axis=3)
    gate = jnp.einsum('bhsd,bhnd->bhsn', q.astype(jnp.float32), k_mean)
    q_block = jnp.arange(S) // MOBA_BLOCK
    past = jnp.arange(nb)[None, :] < q_block[:, None]
    gate = jnp.where(past, gate, NEG)
    n_sel = min(MOBA_TOPK, nb)
    _, sel = lax.top_k(gate, n_sel)

    n_sub = S // Q_SUB
    def to_sub(a):
        return jnp.moveaxis(a.reshape((B, H, n_sub, Q_SUB) + a.shape[3:]), 2, 0)
    q_s = to_sub(q)
    sel_s = to_sub(sel)
    t0 = jnp.arange(n_sub, dtype=jnp.int32) * Q_SUB
    b_idx = jnp.arange(B)[:, None, None]
    h_idx = jnp.arange(H)[None, :, None]
    scale = Dh ** -0.5

    def step(args):
        qb, sb, t = args
        own = t // MOBA_BLOCK
        idx = sb.reshape(B, H, Q_SUB * n_sel)
        k_sel = k_blk[b_idx, h_idx, idx].reshape(B, H, Q_SUB, n_sel, MOBA_BLOCK, Dh)
        v_sel = v_blk[b_idx, h_idx, idx].reshape(B, H, Q_SUB, n_sel, MOBA_BLOCK, Dh)
        k_own = lax.dynamic_index_in_dim(k_blk, own, axis=2, keepdims=False)
        v_own = lax.dynamic_index_in_dim(v_blk, own, axis=2, keepdims=False)
        s_sel = jnp.einsum('bhqd,bhqjkd->bhqjk', qb, k_sel).astype(jnp.float32) * scale
        valid = jnp.arange(n_sel) < own
        s_sel = jnp.where(valid[:, None], s_sel, NEG)
        s_own = jnp.einsum('bhqd,bhkd->bhqk', qb, k_own).astype(jnp.float32) * scale
        q_pos = t + jnp.arange(Q_SUB)
        k_pos = own * MOBA_BLOCK + jnp.arange(MOBA_BLOCK)
        s_own = jnp.where(k_pos[None, :] <= q_pos[:, None], s_own, NEG)
        s_all = jnp.concatenate([s_sel.reshape(B, H, Q_SUB, n_sel * MOBA_BLOCK), s_own], axis=-1)
        p = jax.nn.softmax(s_all, axis=-1).astype(v.dtype)
        p_sel = p[..., :n_sel * MOBA_BLOCK].reshape(B, H, Q_SUB, n_sel, MOBA_BLOCK)
        p_own = p[..., n_sel * MOBA_BLOCK:]
        return (jnp.einsum('bhqjk,bhqjkd->bhqd', p_sel, v_sel)
                + jnp.einsum('bhqk,bhkd->bhqd', p_own, v_own))

    out = lax.map(step, (q_s, sel_s, t0))
    return jnp.moveaxis(out, 0, 2).reshape(B, H, S, Dh)


def conv_gated_ffn(xn, w_up, conv_w, conv_b, w_down):
    h = xn @ w_up
    def shift(a, n):
        return jnp.pad(a[:, :-n], ((0, 0), (n, 0), (0, 0)))
    h = conv_w[2] * h + conv_w[1] * shift(h, 1) + conv_w[0] * shift(h, 2) + conv_b
    gate, val = h[..., :D_FF], h[..., D_FF:]
    return (jax.nn.gelu(gate) * val) @ w_down


def setup_inputs(seed: int = 0) -> dict:
    key = jax.random.key(seed)
    ks = jax.random.split(key, 24)
    f32 = jnp.float32
    def nrm(k, shape, fan_in):
        return jax.random.normal(k, shape, f32) * (fan_in ** -0.5)
    def gain(k, shape):
        return 1.0 + 0.01 * jax.random.normal(k, shape, f32)
    return {
        'x': jax.random.normal(ks[0], (BATCH, SEQ, D_MODEL), f32),
        'mem': jax.random.normal(ks[1], (BATCH, N_MEM_TOKENS, D_MODEL), f32),
        'g_mix': gain(ks[2], (DEPTH, D_MODEL)),
        'g_ffn': gain(ks[3], (DEPTH, D_MODEL)),
        'w_in_a': nrm(ks[4], (N_A_LAYERS, D_MODEL, 2 * MIXER_WIDTH + MEM_WIDTH), D_MODEL),
        'w_out_a': nrm(ks[5], (N_A_LAYERS, MIX_WIDTH, D_MODEL), MIX_WIDTH),
        'g_sgu': gain(ks[6], (N_A_LAYERS, MIXER_WIDTH)),
        'w_s': nrm(ks[7], (N_A_LAYERS, GMLP_GROUPS, CHUNK, CHUNK), CHUNK),
        'b_s': gain(ks[8], (N_A_LAYERS, GMLP_GROUPS, CHUNK)),
        'w_in_b': nrm(ks[9], (N_B_LAYERS, D_MODEL, 3 * MIXER_WIDTH + MEM_WIDTH), D_MODEL),
        'w_out_b': nrm(ks[10], (N_B_LAYERS, MIX_WIDTH, D_MODEL), MIX_WIDTH),
        'g_q_b': gain(ks[11], (N_B_LAYERS, HEAD_DIM)),
        'g_k_b': gain(ks[12], (N_B_LAYERS, HEAD_DIM)),
        'g_mem': gain(ks[13], (D_MODEL,)),
        'w_mem_kv': nrm(ks[14], (D_MODEL, 2 * MEM_WIDTH), D_MODEL),
        'g_km': gain(ks[15], (HEAD_DIM,)),
        'g_qm': gain(ks[16], (DEPTH, HEAD_DIM)),
        'w_up': nrm(ks[17], (DEPTH, D_MODEL, 2 * D_FF), D_MODEL),
        'conv_w': nrm(ks[18], (DEPTH, CONV_WIDTH, 2 * D_FF), CONV_WIDTH),
        'conv_b': 0.01 * jax.random.normal(ks[19], (DEPTH, 2 * D_FF), f32),
        'w_down': nrm(ks[20], (DEPTH, D_FF, D_MODEL), D_FF),
    }


def reference(x, mem, g_mix, g_ffn, w_in_a, w_out_a, g_sgu, w_s, b_s,
              w_in_b, w_out_b, g_q_b, g_k_b, g_mem, w_mem_kv, g_km, g_qm,
              w_up, conv_w, conv_b, w_down):
    B, S, _ = x.shape
    kv = rms_norm(mem, g_mem) @ w_mem_kv
    k_m = rms_norm(kv[..., :MEM_WIDTH].reshape(B, N_MEM_TOKENS, N_MEM_HEADS, HEAD_DIM), g_km)
    v_m = kv[..., MEM_WIDTH:].reshape(B, N_MEM_TOKENS, N_MEM_HEADS, HEAD_DIM)

    h = x
    for i in range(DEPTH):
        xn = rms_norm(h, g_mix[i])
        j = i // 2
        if i % 2 == 0:
            p = xn @ w_in_a[j]
            y_mix = gmlp_spatial_gating(p[..., :2 * MIXER_WIDTH], g_sgu[j], w_s[j], b_s[j])
            y_mem = mem_cross_attention(p[..., 2 * MIXER_WIDTH:], k_m, v_m, g_qm[i])
            w_out = w_out_a[j]
        else:
            p = xn @ w_in_b[j]
            def heads(a, g):
                return rms_norm(a.reshape(B, S, MOBA_HEADS, HEAD_DIM), g).transpose(0, 2, 1, 3)
            q = heads(p[..., :MIXER_WIDTH], g_q_b[j])
            k = heads(p[..., MIXER_WIDTH:2 * MIXER_WIDTH], g_k_b[j])
            v = p[..., 2 * MIXER_WIDTH:3 * MIXER_WIDTH].reshape(B, S, MOBA_HEADS, HEAD_DIM).transpose(0, 2, 1, 3)
            o = moba_attention(q, k, v)
            y_mix = o.transpose(0, 2, 1, 3).reshape(B, S, MIXER_WIDTH)
            y_mem = mem_cross_attention(p[..., 3 * MIXER_WIDTH:], k_m, v_m, g_qm[i])
            w_out = w_out_b[j]
        h = h + jnp.concatenate([y_mix, y_mem], axis=-1) @ w_out
        h = h + conv_gated_ffn(rms_norm(h, g_ffn[i]), w_up[i], conv_w[i], conv_b[i], w_down[i])
    return h
```

```cpp
#include <hip/hip_runtime.h>
#include <cstdio>
#include <cstdint>

#ifndef MK_ONE_LAUNCH
#define MK_ONE_LAUNCH 0
#endif

#define LAS __attribute__((address_space(3)))
#define GAS __attribute__((address_space(1)))
typedef unsigned short f16_t;
typedef _Float16 h16x8 __attribute__((ext_vector_type(8)));
typedef _Float16 h16x4 __attribute__((ext_vector_type(4)));
typedef _Float16 h16x2 __attribute__((ext_vector_type(2)));
typedef float f32x4 __attribute__((ext_vector_type(4)));
typedef float f32x2 __attribute__((ext_vector_type(2)));
typedef unsigned u32x4 __attribute__((ext_vector_type(4)));
typedef unsigned u32x2 __attribute__((ext_vector_type(2)));
typedef GAS unsigned gu32;

constexpr int BATCH = 2, SEQ = 16384, DM = 1024, M = BATCH * SEQ;
constexpr int MIXW = 768, MEMW = 256, NA = 2 * MIXW + MEMW  , NB = 3 * MIXW + MEMW  ;
constexpr int FF = 2816, FF2 = 5632, NMEM = 256, HD = 64;
constexpr int CHUNK = 128, NGRP = 6, MOBA_H = 12, MOBA_BLK = 256, NBLK = SEQ / MOBA_BLK  ;
constexpr float EPS = 1e-6f;
constexpr int UP_UNITS_PER_BATCH = 69;

constexpr size_t MiB = 1u << 20;
constexpr size_t WS_CTL = 0, CTL_BYTES = 2 * MiB;
constexpr size_t WS_WINA = 2 * MiB, WS_WOUTA = 6 * MiB, WS_WINB = 8 * MiB, WS_WOUTB = 13 * MiB;
constexpr size_t WS_WUP0 = 15 * MiB, WS_WUP1 = 26 * MiB, WS_WDN0 = 37 * MiB, WS_WDN1 = 43 * MiB, WS_KV = 49 * MiB;
constexpr size_t WS_A16 = 64 * MiB, WS_Y16 = 128 * MiB, WS_P16 = 192 * MiB, WS_END = 368 * MiB;
constexpr int CW_TMO = 0, CW_BAR = 4096;
constexpr int CW_SS0 = 16384, CW_SSV = CW_SS0 + M, CW_SS1 = CW_SSV + M, CW_SS2 = CW_SS1 + M, CW_SS3 = CW_SS2 + M;
constexpr int CW_KMEAN = CW_SS3 + M;
static_assert((size_t)(CW_KMEAN + BATCH * MOBA_H * NBLK * HD) * 4 <= CTL_BYTES, "ctl");

constexpr int RING_BYTES = 131072, XCH_OFF = RING_BYTES, XCH_BYTES = 16384, MISC_OFF = XCH_OFF + XCH_BYTES;
constexpr int LDS_BYTES = MISC_OFF + 256;
constexpr int NWAVES = 8;

#define LDS_WAIT() asm volatile("s_waitcnt lgkmcnt(0)" ::: "memory")
#define VM_WAIT() asm volatile("s_waitcnt vmcnt(0)" ::: "memory")
#define RLX_AGENT __ATOMIC_RELAXED, __HIP_MEMORY_SCOPE_AGENT

__device__ __forceinline__ unsigned pkh(float lo, float hi) { f32x2 v = {lo, hi}; h16x2 h = __builtin_convertvector(v, h16x2); return __builtin_bit_cast(unsigned, h); }
__device__ __forceinline__ float h2f(f16_t b) { return (float)__builtin_bit_cast(_Float16, b); }
__device__ __forceinline__ f16_t f2h(float f) { return __builtin_bit_cast(f16_t, (_Float16)f); }
__device__ __forceinline__ float gelu_tanh(float x) {
    const float u = x * (1.0f + 0.044715f * x * x);
    const float e = __builtin_amdgcn_exp2f(u * (-2.0f * 0.7978845608028654f * 1.4426950408889634f));
    return x * __builtin_amdgcn_rcpf(1.0f + e);
}
__device__ __forceinline__ float wave_sum(float v) {
#pragma unroll
    for (int o = 1; o < 64; o <<= 1) v += __shfl_xor(v, o);
    return v;
}

namespace pg8 {
constexpr int BM = 256, BK = 64, HALF = 128, HTB = HALF * BK * 2, STAGE_BYTES = 8 * HTB, NXCD = 8, WGM = 8;
__host__ __device__ __forceinline__ int lds_byte(int r, int c) { const int st = (r >> 4) * 2 + (c >> 5), rr = r & 15, cc = c & 31, ob = rr * 64 + cc * 2; return st * 1024 + (ob ^ (((ob >> 9) & 1) << 5)); }
__host__ __device__ __forceinline__ void stage_rc(int b, int& R, int& C) { const int st = b / 1024, sb = b % 1024, swz = sb ^ (((sb >> 9) & 1) << 5); R = (st >> 1) * 16 + swz / 64; C = (st & 1) * 32 + (swz % 64) / 2; }
__host__ __device__ __forceinline__ int perm32(int rho) { const int n = rho >> 4, i = rho & 15; return 8 * (i >> 2) + 4 * n + (i & 3); }

struct Unit { int pm, pn; };
struct Gemm { const f16_t* A; const f16_t* Bt; int K; };

struct Order {
    int nM, nN, nwg, G, c, mode;
    __device__ void init(int nM_, int nN_, int G_, int c_, int mode_) { nM = nM_; nN = nN_; nwg = nM * nN; G = G_; c = c_; mode = mode_; }
    __device__ bool next(int i, Unit& u) const {
        const long L = (long)i * G + c; if (L >= nwg) return false;
        int wgid = (int)L; { const int q = nwg / NXCD, r = nwg % NXCD, xcd = wgid % NXCD, off = wgid / NXCD; wgid = (xcd < r ? xcd * (q + 1) : r * (q + 1) + (xcd - r) * q) + off; }
        const int nig = WGM * nN, gid = wgid / nig, fm = gid * WGM, gsz = (nM - fm) < WGM ? (nM - fm) : WGM;
        u.pm = fm + ((wgid % nig) % gsz); u.pn = (wgid % nig) / gsz; return true;
    }
    __device__ __forceinline__ int arow(int pm) const {
        if (mode == 0) return pm * BM;
        const int b = pm / UP_UNITS_PER_BATCH, i = pm % UP_UNITS_PER_BATCH; int s = (i == 0) ? 0 : 240 * i; if (s > SEQ - 256) s = SEQ - 256; return b * SEQ + s;
    }
    __device__ __forceinline__ int out_lo(int pm) const { return (mode == 0 || (pm % UP_UNITS_PER_BATCH) == 0) ? 0 : 16; }
};

template <class Epi, bool ALIGN_EPI>
__device__ __forceinline__ void gemm_phase(LAS unsigned char* lds, LAS unsigned char* xl, const Gemm g, const Order& S, const Epi& E) {
    const int tid = threadIdx.x, wid = __builtin_amdgcn_readfirstlane(tid >> 6), lane = tid & 63, wr = wid >> 2, wc = wid & 3, fr = lane & 15, fq = lane >> 4;
    const int K = g.K, nt = K / BK;
    unsigned voffA[2], voffB[2];
#pragma unroll
    for (int i = 0; i < 2; ++i) { int R, C; stage_rc(tid * 16 + i * 8192, R, C); const int Rb = Epi::PERM ? ((R & ~31) + perm32(R & 31)) : R;
        voffA[i] = (unsigned)(R * K + C) * 2u; voffB[i] = (unsigned)(Rb * K + C) * 2u; }
    const size_t kstep = (size_t)(BK * 2);
    const size_t hstep = (size_t)HALF * K * 2;
    const size_t tstep = 2 * hstep;
    const size_t rstep = (size_t)K * 2;
    const unsigned ldsw = (unsigned)wid * 1024u;
    const int aoff = lds_byte(wr * 64 + fr, fq * 8), boff = lds_byte(wc * 32 + fr, fq * 8);
#define PG8_SA(b, h) (((b) * 2 + (h)) * HTB)
#define PG8_SB(b, h) ((4 + (b) * 2 + (h)) * HTB)
#define PG8_STAGE(bufoff, gbase, voff) do { _Pragma("unroll") for (int _i = 0; _i < 2; ++_i) \
        __builtin_amdgcn_global_load_lds((const unsigned*)((const char*)(gbase) + (voff)[_i]), (LAS unsigned*)(lds + (bufoff) + ldsw + _i * 8192), 16, 0, 0); } while (0)
#define PG8_LDA(dst, b, h) do { _Pragma("unroll") for (int m = 0; m < 4; ++m) _Pragma("unroll") for (int k = 0; k < 2; ++k) dst[m][k] = *(const LAS h16x8*)(lds + PG8_SA(b, h) + aoff + m * 2048 + k * 1024); } while (0)
#define PG8_LDB(dst, b, h) do { _Pragma("unroll") for (int n = 0; n < 2; ++n) _Pragma("unroll") for (int k = 0; k < 2; ++k) dst[n][k] = *(const LAS h16x8*)(lds + PG8_SB(b, h) + boff + n * 2048 + k * 1024); } while (0)
#define PG8_MMA(ai, bj, At, Bt) do { __builtin_amdgcn_s_setprio(1); _Pragma("unroll") for (int m = 0; m < 4; ++m) _Pragma("unroll") for (int n = 0; n < 2; ++n) _Pragma("unroll") for (int k = 0; k < 2; ++k) \
        acc[ai][bj][m][n] = __builtin_amdgcn_mfma_f32_16x16x32_f16(Bt[n][k], At[m][k], acc[ai][bj][m][n], 0, 0, 0); __builtin_amdgcn_s_setprio(0); } while (0)
#define PG8_WAIT_V(n) asm volatile("s_waitcnt vmcnt(" #n ")" ::: "memory")
#define PG8_WAIT_L(n) asm volatile("s_waitcnt lgkmcnt(" #n ")" ::: "memory")
#define PG8_BAR __builtin_amdgcn_s_barrier()
#define PG8_SCHED __builtin_amdgcn_sched_barrier(0)
    Unit cur, nxt; int ui = 0;
    if (!S.next(0, cur)) return;
    f32x4 acc[2][2][4][2];
#pragma unroll
    for (int a = 0; a < 2; ++a)
#pragma unroll
        for (int b = 0; b < 2; ++b)
#pragma unroll
            for (int m = 0; m < 4; ++m)
#pragma unroll
                for (int n = 0; n < 2; ++n) acc[a][b][m][n] = (f32x4){0.f, 0.f, 0.f, 0.f};
    h16x8 At[4][2], B0[2][2], B1[2][2];
    const char* cA = (const char*)g.A + (size_t)S.arow(cur.pm) * rstep; const char* cB = (const char*)g.Bt + (size_t)cur.pn * tstep;
    PG8_STAGE(PG8_SB(0, 0), cB, voffB); PG8_STAGE(PG8_SB(0, 1), cB + hstep, voffB); PG8_STAGE(PG8_SA(0, 0), cA, voffA); PG8_STAGE(PG8_SA(0, 1), cA + hstep, voffA);
    if (wr == 1) PG8_BAR;
    PG8_WAIT_V(2); PG8_BAR;
    PG8_STAGE(PG8_SB(1, 0), cB + kstep, voffB); PG8_STAGE(PG8_SA(1, 0), cA + kstep, voffA); PG8_STAGE(PG8_SB(1, 1), cB + hstep + kstep, voffB);
    PG8_WAIT_V(6); PG8_BAR;
    for (;;) {
        const bool has_next = S.next(ui + 1, nxt);
        const char* nA = has_next ? (const char*)g.A + (size_t)S.arow(nxt.pm) * rstep : cA; const char* nB = has_next ? (const char*)g.Bt + (size_t)nxt.pn * tstep : cB;
        for (int t = 0; t < nt; t += 2) {
            const bool last = (t == nt - 2);
            const char* a1 = cA + (size_t)(t + 1) * kstep;
            const char* a2 = last ? nA : cA + (size_t)(t + 2) * kstep; const char* b2 = last ? nB : cB + (size_t)(t + 2) * kstep;
            const char* a3 = a2 + kstep; const char* b3 = b2 + kstep;
            PG8_LDB(B0, 0, 0); PG8_LDB(B1, 0, 1); PG8_SCHED; PG8_LDA(At, 0, 0); PG8_STAGE(PG8_SA(1, 1), a1 + hstep, voffA);
            PG8_WAIT_V(8); PG8_WAIT_L(0); PG8_BAR; PG8_MMA(0, 0, At, B0); PG8_MMA(0, 1, At, B1); PG8_BAR; PG8_SCHED;
            PG8_LDA(At, 0, 1); PG8_STAGE(PG8_SB(0, 0), b2, voffB); PG8_STAGE(PG8_SB(0, 1), b2 + hstep, voffB); PG8_STAGE(PG8_SA(0, 0), a2, voffA);
            PG8_WAIT_V(8); PG8_WAIT_L(0); PG8_BAR; PG8_MMA(1, 0, At, B0); PG8_MMA(1, 1, At, B1); PG8_BAR; PG8_SCHED;
            PG8_LDB(B0, 1, 0); PG8_LDB(B1, 1, 1); PG8_SCHED; PG8_LDA(At, 1, 0); PG8_STAGE(PG8_SA(0, 1), a2 + hstep, voffA);
            PG8_WAIT_V(8); PG8_WAIT_L(0); PG8_BAR; PG8_MMA(0, 0, At, B0); PG8_MMA(0, 1, At, B1); PG8_BAR; PG8_SCHED;
            PG8_LDA(At, 1, 1); PG8_STAGE(PG8_SB(1, 0), b3, voffB); PG8_STAGE(PG8_SB(1, 1), b3 + hstep, voffB); PG8_STAGE(PG8_SA(1, 0), a3, voffA);
            PG8_WAIT_V(8); PG8_WAIT_L(0); PG8_BAR; PG8_MMA(1, 0, At, B0); PG8_MMA(1, 1, At, B1); PG8_BAR; PG8_SCHED;
        }
        if constexpr (ALIGN_EPI) { if (wr == 0) PG8_BAR; }
        E(acc, cur, S, wr, wc, fr, fq, xl);
        if (!has_next) break;
#pragma unroll
        for (int a = 0; a < 2; ++a)
#pragma unroll
            for (int b = 0; b < 2; ++b)
#pragma unroll
                for (int m = 0; m < 4; ++m)
#pragma unroll
                    for (int n = 0; n < 2; ++n) acc[a][b][m][n] = (f32x4){0.f, 0.f, 0.f, 0.f};
        cur = nxt; cA = nA; cB = nB; ++ui;
        if constexpr (ALIGN_EPI) { if (wr == 1) PG8_BAR; }
    }
    PG8_WAIT_V(0);
    if constexpr (!ALIGN_EPI) { if (wr == 0) PG8_BAR; }
    PG8_BAR;
#undef PG8_SA
#undef PG8_SB
#undef PG8_STAGE
#undef PG8_LDA
#undef PG8_LDB
#undef PG8_MMA
#undef PG8_WAIT_V
#undef PG8_WAIT_L
#undef PG8_BAR
#undef PG8_SCHED
}

struct EpiInA {
    static constexpr bool PERM = true;
    f16_t* P; const float* ss_in; float* ssv;
    __device__ __forceinline__ void operator()(f32x4 (&acc)[2][2][4][2], const Unit& u, const Order& S, int wr, int wc, int fr, int fq, LAS unsigned char*) const {
        const int row0 = u.pm * BM + wr * 64 + fr, col0 = u.pn * BM + wc * 32 + 8 * fq;
        const bool act = u.pn < 6, stat = (u.pn >= 3 && u.pn < 6);
#pragma unroll
        for (int ai = 0; ai < 2; ++ai)
#pragma unroll
            for (int m = 0; m < 4; ++m) {
                const int row = row0 + ai * HALF + m * 16;
                const float sc = __builtin_amdgcn_rsqf(ss_in[row] * (1.0f / DM) + EPS);
                float sq = 0.f;
#pragma unroll
                for (int bj = 0; bj < 2; ++bj) {
                    f32x4 v0 = acc[ai][bj][m][0] * sc, v1 = acc[ai][bj][m][1] * sc;
                    if (act) {
#pragma unroll
                        for (int e = 0; e < 4; ++e) { v0[e] = gelu_tanh(v0[e]); v1[e] = gelu_tanh(v1[e]); }
                    }
                    sq += (v0[0] * v0[0] + v0[1] * v0[1]) + (v0[2] * v0[2] + v0[3] * v0[3]) + (v1[0] * v1[0] + v1[1] * v1[1]) + (v1[2] * v1[2] + v1[3] * v1[3]);
                    u32x4 w; w.x = pkh(v0[0], v0[1]); w.y = pkh(v0[2], v0[3]); w.z = pkh(v1[0], v1[1]); w.w = pkh(v1[2], v1[3]);
                    *(u32x4*)(P + (size_t)row * NA + col0 + bj * HALF) = w;
                }
                if (stat) { sq += __shfl_xor(sq, 16); sq += __shfl_xor(sq, 32); if (fq == 0) atomicAdd(ssv + row, sq); }
            }
    }
};
struct EpiRes {
    static constexpr bool PERM = false;
    const float* base; float* out; f16_t* a16; float* ss_out;
    __device__ __forceinline__ void operator()(f32x4 (&acc)[2][2][4][2], const Unit& u, const Order& S, int wr, int wc, int fr, int fq, LAS unsigned char*) const {
        const int row0 = u.pm * BM + wr * 64 + fr, col0 = u.pn * BM + wc * 32 + 4 * fq;
#pragma unroll
        for (int ai = 0; ai < 2; ++ai)
#pragma unroll
            for (int m = 0; m < 4; ++m) {
                const int row = row0 + ai * HALF + m * 16; const size_t off = (size_t)row * DM + col0;
                float sq = 0.f;
#pragma unroll
                for (int bj = 0; bj < 2; ++bj)
#pragma unroll
                    for (int n = 0; n < 2; ++n) {
                        const f32x4 bs = *(const f32x4*)(base + off + bj * HALF + n * 16);
                        const f32x4 o = bs + acc[ai][bj][m][n];
                        *(f32x4*)(out + off + bj * HALF + n * 16) = o;
                        if (a16) { sq += (o[0] * o[0] + o[1] * o[1]) + (o[2] * o[2] + o[3] * o[3]);
                            u32x2 w; w.x = pkh(o[0], o[1]); w.y = pkh(o[2], o[3]); *(u32x2*)(a16 + off + bj * HALF + n * 16) = w; }
                    }
                if (a16) { sq += __shfl_xor(sq, 16); sq += __shfl_xor(sq, 32); if (fq == 0) atomicAdd(ss_out + row, sq); }
            }
    }
};
struct EpiUp {
    static constexpr bool PERM = true;
    f16_t* U; const float* ss_in; const float* cw; const float* cb;
    __device__ __forceinline__ void operator()(f32x4 (&acc)[2][2][4][2], const Unit& u, const Order& S, int wr, int wc, int fr, int fq, LAS unsigned char* xl) const {
        const int lane = threadIdx.x & 63;
        const int rs = S.arow(u.pm), lo = S.out_lo(u.pm);
        const int trow0 = wr * 64 + fr;
#pragma unroll
        for (int ai = 0; ai < 2; ++ai)
#pragma unroll
            for (int m = 0; m < 4; ++m) {
                const float sc = __builtin_amdgcn_rsqf(ss_in[rs + trow0 + ai * HALF + m * 16] * (1.0f / DM) + EPS);
#pragma unroll
                for (int bj = 0; bj < 2; ++bj)
#pragma unroll
                    for (int n = 0; n < 2; ++n) acc[ai][bj][m][n] *= sc;
            }
        LAS float* bnd = (LAS float*)xl;
        const int tcol = wc * 32 + 8 * fq;
        if (fr >= 14) {
#pragma unroll
            for (int ai = 0; ai < 2; ++ai)
#pragma unroll
                for (int bj = 0; bj < 2; ++bj)
#pragma unroll
                    for (int n = 0; n < 2; ++n) *(LAS f32x4*)(bnd + ((2 * ai + wr) * 2 + (fr - 14)) * 256 + bj * HALF + tcol + 4 * n) = acc[ai][bj][3][n];
        }
        LDS_WAIT(); __builtin_amdgcn_s_barrier(); asm volatile("" ::: "memory");
        const int l1 = (lane & 48) | ((fr + 15) & 15), l2 = (lane & 48) | ((fr + 14) & 15);
#pragma unroll
        for (int n = 0; n < 2; ++n) {
            const int j0 = u.pn * HALF + tcol + 4 * n;
            f32x4 w[2][3], bb[2];
#pragma unroll
            for (int bj = 0; bj < 2; ++bj) {
#pragma unroll
                for (int k = 0; k < 3; ++k) w[bj][k] = *(const f32x4*)(cw + (size_t)k * FF2 + bj * FF + j0);
                bb[bj] = *(const f32x4*)(cb + bj * FF + j0);
            }
#pragma unroll
            for (int ai = 0; ai < 2; ++ai) {
                const int g = 2 * ai + wr;
                f32x4 q1[2], q2[2];
#pragma unroll
                for (int bj = 0; bj < 2; ++bj) {
                    if (g == 0) { q1[bj] = (f32x4){0.f, 0.f, 0.f, 0.f}; q2[bj] = q1[bj]; }
                    else {
                        const f32x4 r63 = *(const LAS f32x4*)(bnd + ((g - 1) * 2 + 1) * 256 + bj * HALF + tcol + 4 * n);
                        const f32x4 r62 = *(const LAS f32x4*)(bnd + ((g - 1) * 2 + 0) * 256 + bj * HALF + tcol + 4 * n);
                        q1[bj] = r63; q2[bj] = (fr == 0) ? r62 : r63;
                    }
                }
#pragma unroll
                for (int m = 0; m < 4; ++m) {
                    f32x4 h[2];
#pragma unroll
                    for (int bj = 0; bj < 2; ++bj) {
                        const f32x4 x = acc[ai][bj][m][n];
                        f32x4 r1, r2;
#pragma unroll
                        for (int e = 0; e < 4; ++e) { r1[e] = __shfl(x[e], l1); r2[e] = __shfl(x[e], l2); }
                        const f32x4 p1 = (fr >= 1) ? r1 : q1[bj];
                        const f32x4 p2 = (fr >= 2) ? r2 : q2[bj];
                        q1[bj] = r1; q2[bj] = r2;
                        h[bj] = w[bj][2] * x + w[bj][1] * p1 + w[bj][0] * p2 + bb[bj];
                    }
                    f32x4 o;
#pragma unroll
                    for (int e = 0; e < 4; ++e) o[e] = gelu_tanh(h[0][e]) * h[1][e];
                    const int trow = trow0 + ai * HALF + m * 16;
                    if (trow >= lo) { u32x2 pk; pk.x = pkh(o[0], o[1]); pk.y = pkh(o[2], o[3]); *(u32x2*)(U + (size_t)(rs + trow) * FF + j0) = pk; }
                }
            }
        }
    }
};
struct EpiInB {
    static constexpr bool PERM = true;
    f16_t* P; const float* ss_in; const float* gq; const float* gk; float* kmean;
    __device__ __forceinline__ void operator()(f32x4 (&acc)[2][2][4][2], const Unit& u, const Order& S, int wr, int wc, int fr, int fq, LAS unsigned char*) const {
        const int row0 = u.pm * BM + wr * 64 + fr, colh = u.pn * BM + wc * 64;
        const bool nrm = u.pn < 6, isk = (u.pn >= 3 && u.pn < 6);
        f32x4 gv[2][2];
#pragma unroll
        for (int bj = 0; bj < 2; ++bj)
#pragma unroll
            for (int n = 0; n < 2; ++n) gv[bj][n] = nrm ? *(const f32x4*)((isk ? gk : gq) + 32 * bj + 8 * fq + 4 * n) : (f32x4){1.f, 1.f, 1.f, 1.f};
        f32x4 ks[2][2];
#pragma unroll
        for (int bj = 0; bj < 2; ++bj)
#pragma unroll
            for (int n = 0; n < 2; ++n) ks[bj][n] = (f32x4){0.f, 0.f, 0.f, 0.f};
#pragma unroll
        for (int ai = 0; ai < 2; ++ai)
#pragma unroll
            for (int m = 0; m < 4; ++m) {
                const int row = row0 + ai * HALF + m * 16;
                const float sc = __builtin_amdgcn_rsqf(ss_in[row] * (1.0f / DM) + EPS);
                f32x4 v[2][2]; float sq = 0.f;
#pragma unroll
                for (int bj = 0; bj < 2; ++bj)
#pragma unroll
                    for (int n = 0; n < 2; ++n) { v[bj][n] = acc[ai][bj][m][n] * sc; const f32x4 t = v[bj][n]; sq += (t[0] * t[0] + t[1] * t[1]) + (t[2] * t[2] + t[3] * t[3]); }
                float rn = 1.f;
                if (nrm) { sq += __shfl_xor(sq, 16); sq += __shfl_xor(sq, 32); rn = __builtin_amdgcn_rsqf(sq * (1.0f / HD) + EPS); }
#pragma unroll
                for (int bj = 0; bj < 2; ++bj) {
                    const f32x4 a = v[bj][0] * rn * gv[bj][0], b = v[bj][1] * rn * gv[bj][1];
                    ks[bj][0] += a; ks[bj][1] += b;
                    u32x4 w; w.x = pkh(a[0], a[1]); w.y = pkh(a[2], a[3]); w.z = pkh(b[0], b[1]); w.w = pkh(b[2], b[3]);
                    *(u32x4*)(P + (size_t)row * NB + colh + 32 * bj + 8 * fq) = w;
                }
            }
        if (isk) {
            const int b = u.pm / NBLK, blk = u.pm % NBLK, h = (u.pn - 3) * 4 + wc;
            float* dst = kmean + ((size_t)(b * MOBA_H + h) * NBLK + blk) * HD;
#pragma unroll
            for (int bj = 0; bj < 2; ++bj)
#pragma unroll
                for (int n = 0; n < 2; ++n)
#pragma unroll
                    for (int e = 0; e < 4; ++e) {
                        float s = ks[bj][n][e];
                        s += __shfl_xor(s, 1); s += __shfl_xor(s, 2); s += __shfl_xor(s, 4); s += __shfl_xor(s, 8);
                        if (fr == 0) atomicAdd(dst + 32 * bj + 8 * fq + 4 * n + e, s);
                    }
        }
    }
};
}

#define XB_TMO      128
#define XB_XCNT(j)  (256  + 64 * (j))
#define XB_XSUB(j)  (1280 + 64 * (j))
#define XB_XGEN(j)  (2304 + 64 * (j))
#define XB_TOP      3328
#define XB_TOPGEN   3392
#define XCD_BAR_WORDS 3456
#define XB_SPIN_CAP (1u << 18)
__device__ __forceinline__ unsigned xb_ld(unsigned* p)              { return __hip_atomic_load(p, __ATOMIC_RELAXED, __HIP_MEMORY_SCOPE_AGENT); }
__device__ __forceinline__ unsigned xb_add(unsigned* p, unsigned v) { return __hip_atomic_fetch_add(p, v, __ATOMIC_RELAXED, __HIP_MEMORY_SCOPE_AGENT); }
__device__ __forceinline__ unsigned xb_xcc_id() { return (unsigned)__builtin_amdgcn_s_getreg((3 << 11) | 20) & 0xFu; }
#define XB_SPIN(cond, bar) do { unsigned _sp = 0; while (cond) { __builtin_amdgcn_s_sleep(1); \
    if ((++_sp & 255u) == 0u) { if (xb_ld(&(bar)[XB_TMO])) break; if (_sp > XB_SPIN_CAP) { atomicAdd(&(bar)[XB_TMO], 1u); break; } } } } while (0)
struct XcdBarrier { unsigned* bar; unsigned x; volatile LAS unsigned* st; };
__device__ __forceinline__ XcdBarrier xcd_barrier_post(unsigned* bar, volatile LAS unsigned* st) {
    XcdBarrier b; b.bar = bar; b.x = xb_xcc_id(); b.st = st;
    if (threadIdx.x == 0) (void)xb_add(&bar[XB_XCNT(b.x)], 1u);
    return b;
}
__device__ __forceinline__ void xcd_barrier_complete(unsigned* bar, unsigned x, unsigned& nloc, unsigned& nx) {
    const unsigned G = gridDim.x * gridDim.y * gridDim.z;
    unsigned sum, cnt, mine, sp = 0u;
    for (;;) {
        sum = 0u; cnt = 0u; mine = 0u;
#pragma unroll
        for (unsigned j = 0; j < 16; ++j) { const unsigned c = xb_ld(&bar[XB_XCNT(j)]); sum += c; cnt += (c > 0u) ? 1u : 0u; mine = (j == x) ? c : mine; }
        if (sum == G) break;
        __builtin_amdgcn_s_sleep(1);
        if ((++sp & 255u) == 0u) { if (xb_ld(&bar[XB_TMO])) break; if (sp > XB_SPIN_CAP) { atomicAdd(&bar[XB_TMO], 1u); break; } }
    }
    nloc = mine > 0u ? mine : 1u; nx = cnt > 0u ? cnt : 1u;
}
__device__ __forceinline__ void xcd_barrier(const XcdBarrier& b) {
    asm volatile("s_waitcnt vmcnt(0)" ::: "memory");
    __syncthreads();
    if (threadIdx.x == 0) {
        unsigned* bar = b.bar;
        __builtin_amdgcn_s_waitcnt(0);
        unsigned nloc = b.st[0], nx = b.st[1];
        if (nloc == 0u) { xcd_barrier_complete(bar, b.x, nloc, nx); b.st[0] = nloc; b.st[1] = nx; }
        const unsigned old = xb_add(&bar[XB_XSUB(b.x)], 1u);
        const unsigned gen = old / nloc;
        if (old + 1u == (gen + 1u) * nloc) {
            __builtin_amdgcn_fence(__ATOMIC_RELEASE, "agent");
            asm volatile("s_waitcnt vmcnt(0)" ::: "memory");
            const unsigned og = xb_add(&bar[XB_TOP], 1u);
            const unsigned tg = og / nx;
            if (og + 1u == (tg + 1u) * nx) xb_add(&bar[XB_TOPGEN], 1u);
            else XB_SPIN(xb_ld(&bar[XB_TOPGEN]) == tg, bar);
            __builtin_amdgcn_fence(__ATOMIC_ACQUIRE, "agent");
            xb_add(&bar[XB_XGEN(b.x)], 1u);
            asm volatile("s_waitcnt vmcnt(0)" ::: "memory");
        } else {
            XB_SPIN(xb_ld(&bar[XB_XGEN(b.x)]) == gen, bar);
            __builtin_amdgcn_fence(__ATOMIC_ACQUIRE, "agent");
            asm volatile("s_waitcnt vmcnt(0)" ::: "memory");
        }
    }
    __syncthreads();
}

struct Args { const float* in[21]; float* out; unsigned char* ws; int ph_lo, ph_hi; };
struct Frame {
    LAS unsigned char* lds; volatile LAS unsigned* MISC; gu32* ctl;
    int tid, lane, wave, vcu, G;
};

__device__ __forceinline__ void p0_transpose_item(const float* W, int K, int N, f16_t* WT, const float* gain, LAS float* scr, int k0, int n0, int dst0, int lane) {
#pragma unroll 8
    for (int i = 0; i < 32; ++i) { const int kk = 2 * i + (lane >> 5); float v = W[(size_t)(k0 + kk) * N + n0 + (lane & 31)]; if (gain) v *= gain[k0 + kk]; scr[kk * 33 + (lane & 31)] = v; }
    LDS_WAIT(); asm volatile("" ::: "memory");
    const int c = lane & 7;
#pragma unroll
    for (int j = 0; j < 4; ++j) { const int n = (lane >> 3) + 8 * j; const LAS float* s = scr + (8 * c) * 33 + n;
        u32x4 o; o.x = pkh(s[0 * 33], s[1 * 33]); o.y = pkh(s[2 * 33], s[3 * 33]); o.z = pkh(s[4 * 33], s[5 * 33]); o.w = pkh(s[6 * 33], s[7 * 33]);
        *(GAS u32x4*)(WT + (size_t)(dst0 + n) * K + k0 + 8 * c) = o; }
    LDS_WAIT(); asm volatile("" ::: "memory");
}
__device__ __forceinline__ int map_ident(int n0) { return n0; }
__device__ __forceinline__ int map_heads(int n0) { const int t = n0 >> 8, l = n0 & 255, wc = l >> 6, bj = (l >> 5) & 1; return (t << 8) + 128 * bj + 32 * wc; }
__device__ __forceinline__ int map_up(int n0) { const int bj = n0 >= FF ? 1 : 0, j = n0 - bj * FF; return 256 * (j >> 7) + 128 * bj + (j & 127); }

template <int MAP>
__device__ __forceinline__ void p0_matrix(const Frame& F, const float* W, int K, int N, f16_t* WT, const float* gain, int& base, int gw, int NGW, LAS float* scr) {
    const int nblk = N / 32, items = (K / 64) * nblk;
    int first = gw - (base % NGW); if (first < 0) first += NGW;
    for (int it = first; it < items; it += NGW) {
        const int kb = it / nblk, nb = it % nblk, n0 = 32 * nb;
        const int d0 = (MAP == 0) ? map_ident(n0) : (MAP == 1) ? map_heads(n0) : map_up(n0);
        p0_transpose_item(W, K, N, WT, gain, scr, 64 * kb, n0, d0, F.lane);
    }
    base += items;
}

__device__ __forceinline__ void p0_prologue(const Frame& F, const Args& a) {
    unsigned char* ws = a.ws;
    LAS float* scr = (LAS float*)(F.lds + F.wave * 16384);
    const int gw = F.vcu * NWAVES + F.wave, NGW = F.G * NWAVES;
    int base = 0;
    p0_matrix<0>(F, a.in[4], DM, NA, (f16_t*)(ws + WS_WINA), a.in[2], base, gw, NGW, scr);
    p0_matrix<0>(F, a.in[5], DM, DM, (f16_t*)(ws + WS_WOUTA), nullptr, base, gw, NGW, scr);
    p0_matrix<1>(F, a.in[9], DM, NB, (f16_t*)(ws + WS_WINB), a.in[2] + DM, base, gw, NGW, scr);
    p0_matrix<0>(F, a.in[10], DM, DM, (f16_t*)(ws + WS_WOUTB), nullptr, base, gw, NGW, scr);
    p0_matrix<2>(F, a.in[17], DM, FF2, (f16_t*)(ws + WS_WUP0), a.in[3], base, gw, NGW, scr);
    p0_matrix<2>(F, a.in[17] + (size_t)DM * FF2, DM, FF2, (f16_t*)(ws + WS_WUP1), a.in[3] + DM, base, gw, NGW, scr);
    p0_matrix<0>(F, a.in[20], FF, DM, (f16_t*)(ws + WS_WDN0), nullptr, base, gw, NGW, scr);
    p0_matrix<0>(F, a.in[20] + (size_t)FF * DM, FF, DM, (f16_t*)(ws + WS_WDN1), nullptr, base, gw, NGW, scr);
    {
        const float* x = a.in[0]; f16_t* A16 = (f16_t*)(ws + WS_A16); float* ss0 = (float*)(F.ctl + CW_SS0);
        for (int m = gw; m < M; m += NGW) {
            const GAS f32x4* xr = (const GAS f32x4*)(x + (size_t)m * DM) + F.lane;
            f32x4 v[4]; float s = 0.f;
#pragma unroll
            for (int j = 0; j < 4; ++j) { v[j] = xr[64 * j]; s += (v[j].x * v[j].x + v[j].y * v[j].y) + (v[j].z * v[j].z + v[j].w * v[j].w); }
            s = wave_sum(s);
            if (F.lane == 0) ss0[m] = s;
            GAS u32x2* o8 = (GAS u32x2*)(A16 + (size_t)m * DM) + F.lane;
#pragma unroll
            for (int j = 0; j < 4; ++j) { u32x2 w; w.x = pkh(v[j].x, v[j].y); w.y = pkh(v[j].z, v[j].w); o8[64 * j] = w; }
        }
    }
    __syncthreads();
    {
        const float* mem = a.in[1]; const float* gmem = a.in[13]; const float* wkv = a.in[14]; float* KV = (float*)(ws + WS_KV);
        LAS float* rowb = (LAS float*)F.lds;
        LAS float* red = (LAS float*)(F.lds + 8192);
        for (int rp = F.vcu; rp < 256; rp += F.G) {
            if (F.wave < 2) {
                const float* mr = mem + (size_t)(2 * rp + F.wave) * DM; float s = 0.f;
                for (int j = F.lane; j < DM; j += 64) { const float v = mr[j]; s += v * v; }
                s = wave_sum(s);
                const float rn = 1.0f / sqrtf(s * (1.0f / DM) + EPS);
                for (int j = F.lane; j < DM; j += 64) rowb[F.wave * DM + j] = mr[j] * rn * gmem[j];
            }
            __syncthreads();
            float a0 = 0.f, a1 = 0.f; const int c = F.tid;
            for (int k = 0; k < DM; ++k) { const float w = wkv[(size_t)k * 512 + c]; a0 += rowb[k] * w; a1 += rowb[DM + k] * w; }
            KV[(size_t)(2 * rp) * 512 + c] = a0; KV[(size_t)(2 * rp + 1) * 512 + c] = a1;
            __syncthreads();
        }
        (void)red;
    }
}

__device__ __forceinline__ void xattn_chunk(const Frame& F, const Args& a, int chunk, const f16_t* P, int ldp, int qcol0, const float* gqm, f16_t* Y) {
    const float* KV = (const float*)(a.ws + WS_KV); const float* gkm = a.in[15];
    const int r0 = chunk * CHUNK, b = r0 / SEQ;
    LAS float* rnk = (LAS float*)(F.lds + 65536);
    for (int idx = F.tid; idx < 1024; idx += 512) {
        const int key = idx >> 2, hh = idx & 3; const float* kr = KV + (size_t)(b * NMEM + key) * 512 + hh * HD; float s = 0.f;
        for (int d = 0; d < HD; ++d) s += kr[d] * kr[d];
        rnk[idx] = 1.0f / sqrtf(s * (1.0f / HD) + EPS);
    }
    __syncthreads();
    const int tt = F.tid & 127, hh = F.tid >> 7, row = r0 + tt;
    float q[HD];
    { const f16_t* qp = P + (size_t)row * ldp + qcol0 + hh * HD; float s = 0.f;
#pragma unroll
      for (int d = 0; d < HD; ++d) { q[d] = h2f(qp[d]); s += q[d] * q[d]; }
      const float rn = 1.0f / sqrtf(s * (1.0f / HD) + EPS);
#pragma unroll
      for (int d = 0; d < HD; ++d) q[d] = q[d] * rn * gqm[d] * gkm[d] * 0.125f; }
    float o[HD];
#pragma unroll
    for (int d = 0; d < HD; ++d) o[d] = 0.f;
    float mx = -1e30f, l = 0.f;
    for (int k = 0; k < NMEM; ++k) {
        const float* kr = KV + (size_t)(b * NMEM + k) * 512 + hh * HD; float s = 0.f;
#pragma unroll
        for (int d = 0; d < HD; ++d) s += q[d] * kr[d];
        s *= rnk[k * 4 + hh];
        if (s > mx) { const float f = __expf(mx - s); l *= f;
#pragma unroll
            for (int d = 0; d < HD; ++d) o[d] *= f;
            mx = s; }
        const float p = __expf(s - mx); l += p;
        const float* vr = kr + 256;
#pragma unroll
        for (int d = 0; d < HD; ++d) o[d] += p * vr[d];
    }
    const float il = 1.0f / l;
    f16_t* yp = Y + (size_t)row * DM + MIXW + hh * HD;
#pragma unroll
    for (int d = 0; d < HD; d += 2) *(unsigned*)(yp + d) = pkh(o[d] * il, o[d + 1] * il);
    __syncthreads();
}

__device__ __forceinline__ void mixer_a(const Frame& F, const Args& a) {
    const f16_t* P = (const f16_t*)(a.ws + WS_P16); f16_t* Y = (f16_t*)(a.ws + WS_Y16);
    const float* ssv = (const float*)(F.ctl + CW_SSV); const float* gsgu = a.in[6]; const float* wsp = a.in[7]; const float* bsp = a.in[8];
    LAS float* Wl = (LAS float*)F.lds; LAS float* Vl = (LAS float*)(F.lds + 65536); LAS float* rv = (LAS float*)(F.lds + XCH_OFF);
    for (int chunk = F.vcu; chunk < M / CHUNK; chunk += F.G) {
        const int r0 = chunk * CHUNK;
        if (F.tid < CHUNK) rv[F.tid] = 1.0f / sqrtf(ssv[r0 + F.tid] * (1.0f / MIXW) + EPS);
        __syncthreads();
        for (int g = 0; g < NGRP; ++g) {
            for (int idx = F.tid; idx < CHUNK * CHUNK; idx += 512) {
                const int t = idx >> 7, s = idx & 127;
                Wl[idx] = (s <= t) ? wsp[(size_t)g * CHUNK * CHUNK + idx] : 0.f;
                Vl[idx] = h2f(P[(size_t)(r0 + t) * NA + MIXW + g * 128 + s]) * rv[t] * gsgu[g * 128 + s];
            }
            __syncthreads();
            const int d = F.tid & 127, tq = F.tid >> 7;
            float acc[32];
#pragma unroll
            for (int i = 0; i < 32; ++i) acc[i] = 0.f;
            const int smax = 32 * tq + 32;
            for (int s = 0; s < smax; ++s) {
                const float v = Vl[s * 128 + d];
#pragma unroll
                for (int i = 0; i < 32; ++i) acc[i] += Wl[(32 * tq + i) * 128 + s] * v;
            }
#pragma unroll
            for (int i = 0; i < 32; ++i) {
                const int t = 32 * tq + i;
                const float mixed = acc[i] + bsp[g * CHUNK + t];
                const float uu = h2f(P[(size_t)(r0 + t) * NA + g * 128 + d]);
                Y[(size_t)(r0 + t) * DM + g * 128 + d] = f2h(uu * mixed);
            }
            __syncthreads();
        }
        xattn_chunk(F, a, chunk, P, NA, 2 * MIXW, a.in[16], Y);
    }
}

__device__ __forceinline__ void mixer_b(const Frame& F, const Args& a) {
    const f16_t* P = (const f16_t*)(a.ws + WS_P16); f16_t* Y = (f16_t*)(a.ws + WS_Y16);
    const float* kmean = (const float*)(F.ctl + CW_KMEAN);
    for (int unit = F.vcu; unit < BATCH * NBLK * (MOBA_H / 2); unit += F.G) {
        const int hp = unit % (MOBA_H / 2), qb = (unit / (MOBA_H / 2)) % NBLK, b = unit / ((MOBA_H / 2) * NBLK);
        const int qi = F.tid & 255, h = 2 * hp + (F.tid >> 8);
        const int row = b * SEQ + qb * MOBA_BLK + qi;
        float q[HD];
        { const f16_t* qp = P + (size_t)row * NB + h * HD;
#pragma unroll
          for (int d = 0; d < HD; ++d) q[d] = h2f(qp[d]); }
        float g0 = -3e38f, g1 = -3e38f, g2 = -3e38f; int i0 = 0, i1 = 0, i2 = 0;
        for (int j = 0; j < qb; ++j) {
            const float* km = kmean + ((size_t)(b * MOBA_H + h) * NBLK + j) * HD; float s = 0.f;
#pragma unroll
            for (int d = 0; d < HD; ++d) s += q[d] * km[d];
            s *= (1.0f / MOBA_BLK);
            if (s > g0) { g2 = g1; i2 = i1; g1 = g0; i1 = i0; g0 = s; i0 = j; }
            else if (s > g1) { g2 = g1; i2 = i1; g1 = s; i1 = j; }
            else if (s > g2) { g2 = s; i2 = j; }
        }
        const int nsel = qb < 3 ? qb : 3;
        float o[HD];
#pragma unroll
        for (int d = 0; d < HD; ++d) { o[d] = 0.f; q[d] *= 0.125f; }
        float mx = -1e30f, l = 0.f;
        for (int slot = 0; slot <= nsel; ++slot) {
            const int blk = (slot == nsel) ? qb : (slot == 0 ? i0 : (slot == 1 ? i1 : i2));
            const int nk = (slot == nsel) ? qi + 1 : MOBA_BLK;
            const f16_t* kb = P + (size_t)(b * SEQ + blk * MOBA_BLK) * NB + MIXW + h * HD;
            for (int kk = 0; kk < nk; ++kk) {
                const f16_t* kr = kb + (size_t)kk * NB; float s = 0.f;
#pragma unroll
                for (int d8 = 0; d8 < HD; d8 += 8) { const h16x8 kv = *(const h16x8*)(kr + d8);
#pragma unroll
                    for (int e = 0; e < 8; ++e) s += q[d8 + e] * (float)kv[e]; }
                if (s > mx) { const float f = __expf(mx - s); l *= f;
#pragma unroll
                    for (int d = 0; d < HD; ++d) o[d] *= f;
                    mx = s; }
                const float p = __expf(s - mx); l += p;
                const f16_t* vr = kr + MIXW;
#pragma unroll
                for (int d8 = 0; d8 < HD; d8 += 8) { const h16x8 vv = *(const h16x8*)(vr + d8);
#pragma unroll
                    for (int e = 0; e < 8; ++e) o[d8 + e] += p * (float)vv[e]; }
            }
        }
        const float il = 1.0f / l;
        f16_t* yp = Y + (size_t)row * DM + h * HD;
#pragma unroll
        for (int d = 0; d < HD; d += 2) *(unsigned*)(yp + d) = pkh(o[d] * il, o[d + 1] * il);
    }
    __syncthreads();
    for (int chunk = F.vcu; chunk < M / CHUNK; chunk += F.G) xattn_chunk(F, a, chunk, P, NB, 3 * MIXW, a.in[16] + HD, Y);
}

__global__ void __launch_bounds__(NWAVES * 64, 2) fwd_kernel(Args args) {
    extern __shared__ __attribute__((aligned(16))) unsigned char lds_raw[];
    Frame F;
    F.lds = (LAS unsigned char*)lds_raw;
    F.MISC = (volatile LAS unsigned*)(F.lds + MISC_OFF);
    F.tid = threadIdx.x; F.lane = F.tid & 63; F.wave = __builtin_amdgcn_readfirstlane(F.tid >> 6);
    F.G = gridDim.x; { const int bx = blockIdx.x; F.vcu = (F.G % 8 == 0) ? (bx % 8) * (F.G / 8) + bx / 8 : bx; }
    unsigned char* ws = args.ws;
    F.ctl = (gu32*)(ws + WS_CTL);
    for (int u = F.tid; u < 64; u += NWAVES * 64) ((LAS unsigned*)(F.lds + MISC_OFF))[u] = 0u;
    __syncthreads();
    const int lo = args.ph_lo, hi = args.ph_hi;
    XcdBarrier bar; bar.bar = (unsigned*)(F.ctl + CW_BAR); bar.x = 0; bar.st = nullptr;
    if (hi - lo > 1) bar = xcd_barrier_post((unsigned*)(F.ctl + CW_BAR), F.MISC + 8);
#define IN(k) (lo <= (k) && (k) < hi)
#define SEAM(k) do { if (IN(k) && IN((k) + 1)) xcd_barrier(bar); } while (0)
    LAS unsigned char* ring = F.lds; LAS unsigned char* xl = F.lds + XCH_OFF;
    f16_t* A16 = (f16_t*)(ws + WS_A16); f16_t* Y16 = (f16_t*)(ws + WS_Y16); f16_t* P16 = (f16_t*)(ws + WS_P16);
    float* SS0 = (float*)(F.ctl + CW_SS0); float* SSV = (float*)(F.ctl + CW_SSV); float* SS1 = (float*)(F.ctl + CW_SS1); float* SS2 = (float*)(F.ctl + CW_SS2); float* SS3 = (float*)(F.ctl + CW_SS3);
    float* KMEAN = (float*)(F.ctl + CW_KMEAN);
    const int c = (int)blockIdx.x;

    if (IN(0)) { p0_prologue(F, args); } SEAM(0);
    if (IN(1)) { pg8::Gemm g{A16, (const f16_t*)(ws + WS_WINA), DM}; pg8::Order S; S.init(M / 256, NA / 256, F.G, c, 0);
        pg8::EpiInA E{P16, SS0, SSV}; pg8::gemm_phase<pg8::EpiInA, true>(ring, xl, g, S, E); } SEAM(1);
    if (IN(2)) { mixer_a(F, args); } SEAM(2);
    if (IN(3)) { pg8::Gemm g{Y16, (const f16_t*)(ws + WS_WOUTA), DM}; pg8::Order S; S.init(M / 256, DM / 256, F.G, c, 0);
        pg8::EpiRes E{args.in[0], args.out, A16, SS1}; pg8::gemm_phase<pg8::EpiRes, true>(ring, xl, g, S, E); } SEAM(3);
    if (IN(4)) { pg8::Gemm g{A16, (const f16_t*)(ws + WS_WUP0), DM}; pg8::Order S; S.init(BATCH * UP_UNITS_PER_BATCH, FF2 / 256, F.G, c, 1);
        pg8::EpiUp E{P16, SS1, args.in[18], args.in[19]}; pg8::gemm_phase<pg8::EpiUp, true>(ring, xl, g, S, E); } SEAM(4);
    if (IN(5)) { pg8::Gemm g{P16, (const f16_t*)(ws + WS_WDN0), FF}; pg8::Order S; S.init(M / 256, DM / 256, F.G, c, 0);
        pg8::EpiRes E{args.out, args.out, A16, SS2}; pg8::gemm_phase<pg8::EpiRes, true>(ring, xl, g, S, E); } SEAM(5);
    if (IN(6)) { pg8::Gemm g{A16, (const f16_t*)(ws + WS_WINB), DM}; pg8::Order S; S.init(M / 256, NB / 256, F.G, c, 0);
        pg8::EpiInB E{P16, SS2, args.in[11], args.in[12], KMEAN}; pg8::gemm_phase<pg8::EpiInB, true>(ring, xl, g, S, E); } SEAM(6);
    if (IN(7)) { mixer_b(F, args); } SEAM(7);
    if (IN(8)) { pg8::Gemm g{Y16, (const f16_t*)(ws + WS_WOUTB), DM}; pg8::Order S; S.init(M / 256, DM / 256, F.G, c, 0);
        pg8::EpiRes E{args.out, args.out, A16, SS3}; pg8::gemm_phase<pg8::EpiRes, true>(ring, xl, g, S, E); } SEAM(8);
    if (IN(9)) { pg8::Gemm g{A16, (const f16_t*)(ws + WS_WUP1), DM}; pg8::Order S; S.init(BATCH * UP_UNITS_PER_BATCH, FF2 / 256, F.G, c, 1);
        pg8::EpiUp E{P16, SS3, args.in[18] + 3 * FF2, args.in[19] + FF2}; pg8::gemm_phase<pg8::EpiUp, true>(ring, xl, g, S, E); } SEAM(9);
    if (IN(10)) { pg8::Gemm g{P16, (const f16_t*)(ws + WS_WDN1), FF}; pg8::Order S; S.init(M / 256, DM / 256, F.G, c, 0);
        pg8::EpiRes E{args.out, args.out, nullptr, nullptr}; pg8::gemm_phase<pg8::EpiRes, true>(ring, xl, g, S, E); }
#undef IN
#undef SEAM
}

extern "C" void kernel_launch(void* const* d_in, const int* in_sizes, int n_in, void* d_out, int out_size, void* d_ws, size_t ws_size, hipStream_t stream) {
    static int grid = 0;
    if (grid == 0) {
        if (n_in != 21 || in_sizes[0] != M * DM || out_size != M * DM || ws_size < WS_END) { fprintf(stderr, "kernel_launch: unexpected shapes (n_in %d, in0 %d, out %d, ws %zu); nothing launched\n", n_in, n_in > 0 ? in_sizes[0] : -1, out_size, ws_size); grid = -1; return; }
        int dev = 0, cus = 0;
        if (hipGetDevice(&dev) != hipSuccess || hipDeviceGetAttribute(&cus, hipDeviceAttributeMultiprocessorCount, dev) != hipSuccess) { grid = -1; return; }
        if (hipFuncSetAttribute((const void*)fwd_kernel, hipFuncAttributeMaxDynamicSharedMemorySize, LDS_BYTES) != hipSuccess) { fprintf(stderr, "kernel_launch: hipFuncSetAttribute failed\n"); grid = -1; return; }
        (void)hipGetLastError();
        grid = cus;
    }
    if (grid < 0) return;
    if (hipMemsetAsync((char*)d_ws + WS_CTL, 0, CTL_BYTES, stream) != hipSuccess) return;
    Args a{};
    for (int i = 0; i < 21; ++i) a.in[i] = (const float*)d_in[i];
    a.out = (float*)d_out; a.ws = (unsigned char*)d_ws;
#if MK_ONE_LAUNCH
    a.ph_lo = 0; a.ph_hi = 11;
    hipLaunchKernelGGL(fwd_kernel, dim3(grid), dim3(NWAVES * 64), LDS_BYTES, stream, a);
#else
    for (int p = 0; p < 11; ++p) { a.ph_lo = p; a.ph_hi = p + 1; hipLaunchKernelGGL(fwd_kernel, dim3(grid), dim3(NWAVES * 64), LDS_BYTES, stream, a); }
#endif
}
```

```cpp
#include <hip/hip_runtime.h>
#include <cstdio>
#include <cstdint>

#ifndef MK_ONE_LAUNCH
#define MK_ONE_LAUNCH 1
#endif

#define LAS __attribute__((address_space(3)))
#define GAS __attribute__((address_space(1)))
typedef unsigned short f16_t;
typedef _Float16 h16x8 __attribute__((ext_vector_type(8)));
typedef _Float16 h16x4 __attribute__((ext_vector_type(4)));
typedef _Float16 h16x2 __attribute__((ext_vector_type(2)));
typedef float f32x4 __attribute__((ext_vector_type(4)));
typedef float f32x2 __attribute__((ext_vector_type(2)));
typedef unsigned u32x4 __attribute__((ext_vector_type(4)));
typedef unsigned u32x2 __attribute__((ext_vector_type(2)));
typedef GAS unsigned gu32;

constexpr int BATCH = 2, SEQ = 16384, DM = 1024, M = BATCH * SEQ;
constexpr int MIXW = 768, MEMW = 256, NA = 2 * MIXW + MEMW  , NB = 3 * MIXW + MEMW  ;
constexpr int FF = 2816, FF2 = 5632, NMEM = 256, HD = 64;
constexpr int CHUNK = 128, NGRP = 6, MOBA_H = 12, MOBA_BLK = 256, NBLK = SEQ / MOBA_BLK  ;
constexpr float EPS = 1e-6f;
constexpr int UP_UNITS_PER_BATCH = 69;

constexpr size_t MiB = 1u << 20;
constexpr size_t WS_CTL = 0, CTL_BYTES = 2 * MiB;
constexpr size_t WS_WINA = 2 * MiB, WS_WOUTA = 6 * MiB, WS_WINB = 8 * MiB, WS_WOUTB = 13 * MiB;
constexpr size_t WS_WUP0 = 15 * MiB, WS_WUP1 = 26 * MiB, WS_WDN0 = 37 * MiB, WS_WDN1 = 43 * MiB, WS_KV = 49 * MiB, WS_KM16 = 50 * MiB, WS_VM16 = 51 * MiB, WS_LIST = 52 * MiB, WS_OFFS = 55 * MiB, WS_PL = 56 * MiB, WS_MEM16 = 61 * MiB, WS_WKV = 62 * MiB, WS_W16S = 63 * MiB;
constexpr size_t WS_A16 = 64 * MiB, WS_Y16 = 128 * MiB, WS_P16 = 192 * MiB, WS_PO = 368 * MiB, WS_END = 512 * MiB;
constexpr int CW_TMO = 0, CW_BAR = 4096, CW_QUEUE = 8192;
constexpr int CW_SS0 = 16384, CW_SSV = CW_SS0 + M, CW_SS1 = CW_SSV + M, CW_SS2 = CW_SS1 + M, CW_SS3 = CW_SS2 + M;
constexpr int CW_SSM = CW_SS3 + M;
constexpr int CW_KMEAN = CW_SSM + 512;
static_assert((size_t)(CW_KMEAN + BATCH * MOBA_H * NBLK * HD) * 4 <= CTL_BYTES, "ctl");

constexpr int RING_BYTES = 131072, XCH_OFF = RING_BYTES, XCH_BYTES = 16384, MISC_OFF = 163840 - 256;
constexpr int LDS_BYTES = 163840;
constexpr int NWAVES = 8;

#define LDS_WAIT() asm volatile("s_waitcnt lgkmcnt(0)" ::: "memory")
#define VM_WAIT() asm volatile("s_waitcnt vmcnt(0)" ::: "memory")
#define RLX_AGENT __ATOMIC_RELAXED, __HIP_MEMORY_SCOPE_AGENT

__device__ __forceinline__ unsigned pkh(float lo, float hi) { f32x2 v = {lo, hi}; h16x2 h = __builtin_convertvector(v, h16x2); return __builtin_bit_cast(unsigned, h); }
__device__ __forceinline__ unsigned pk8(float a, float b, float c, float d) { int w = __builtin_amdgcn_cvt_pk_fp8_f32(a, b, 0, false); w = __builtin_amdgcn_cvt_pk_fp8_f32(c, d, w, true); return (unsigned)w; }
constexpr float F8_SA = 8.0f, F8_SW = 512.0f, F8_SY = 32.0f;
__device__ __forceinline__ float h2f(f16_t b) { return (float)__builtin_bit_cast(_Float16, b); }
__device__ __forceinline__ f16_t f2h(float f) { return __builtin_bit_cast(f16_t, (_Float16)f); }
__device__ __forceinline__ float gelu_tanh(float x) {
    const float u = x * (1.0f + 0.044715f * x * x);
    const float e = __builtin_amdgcn_exp2f(u * (-2.0f * 0.7978845608028654f * 1.4426950408889634f));
    return x * __builtin_amdgcn_rcpf(1.0f + e);
}
__device__ __forceinline__ f32x2 gelu_tanh2(f32x2 x) {
    constexpr float C = -2.0f * 0.7978845608028654f * 1.4426950408889634f;
    const f32x2 t = (x * x) * (0.044715f * C) + C;
    const f32x2 a = x * t;
    f32x2 e; e.x = __builtin_amdgcn_exp2f(a.x); e.y = __builtin_amdgcn_exp2f(a.y);
    const f32x2 d = e + 1.0f;
    f32x2 r; r.x = __builtin_amdgcn_rcpf(d.x); r.y = __builtin_amdgcn_rcpf(d.y);
    return x * r;
}
__device__ __forceinline__ float wave_sum(float v) {
#pragma unroll
    for (int o = 1; o < 64; o <<= 1) v += __shfl_xor(v, o);
    return v;
}

namespace pg8 {
constexpr int BM = 256, BK = 64, HALF = 128, HTB = HALF * BK * 2, STAGE_BYTES = 8 * HTB, NXCD = 8, WGM = 8;
__host__ __device__ __forceinline__ int lds_byte(int r, int c) { const int st = (r >> 4) * 2 + (c >> 5), rr = r & 15, cc = c & 31, ob = rr * 64 + cc * 2; return st * 1024 + (ob ^ (((ob >> 9) & 1) << 5)); }
__host__ __device__ __forceinline__ void stage_rc(int b, int& R, int& C) { const int st = b / 1024, sb = b % 1024, swz = sb ^ (((sb >> 9) & 1) << 5); R = (st >> 1) * 16 + swz / 64; C = (st & 1) * 32 + (swz % 64) / 2; }
__host__ __device__ __forceinline__ int perm32(int rho) { const int n = rho >> 4, i = rho & 15; return 8 * (i >> 2) + 4 * n + (i & 3); }

struct Unit { int pm, pn; };
struct Gemm { const f16_t* A; const f16_t* Bt; int K; };

struct Order {
    int nM, nN, nwg, G, c, mode;
    __device__ void init(int nM_, int nN_, int G_, int c_, int mode_) { nM = nM_; nN = nN_; nwg = nM * nN; G = G_; c = c_; mode = mode_; }
    __device__ bool next(int i, Unit& u) const {
        const long L = (long)i * G + c; if (L >= nwg) return false;
        int wgid = (int)L; { const int q = nwg / NXCD, r = nwg % NXCD, xcd = wgid % NXCD, off = wgid / NXCD; wgid = (xcd < r ? xcd * (q + 1) : r * (q + 1) + (xcd - r) * q) + off; }
        const int nig = WGM * nN, gid = wgid / nig, fm = gid * WGM, gsz = (nM - fm) < WGM ? (nM - fm) : WGM;
        u.pm = fm + ((wgid % nig) % gsz); u.pn = (wgid % nig) / gsz; return true;
    }
    __device__ __forceinline__ int arow(int pm) const {
        if (mode == 0) return pm * BM;
        const int b = pm / UP_UNITS_PER_BATCH, i = pm % UP_UNITS_PER_BATCH; int s = (i == 0) ? 0 : 240 * i; if (s > SEQ - 256) s = SEQ - 256; return b * SEQ + s;
    }
    __device__ __forceinline__ int out_lo(int pm) const { return (mode == 0 || (pm % UP_UNITS_PER_BATCH) == 0) ? 0 : 16; }
};

typedef int i32x8 __attribute__((ext_vector_type(8)));
__device__ __forceinline__ i32x8 cat_frag(h16x8 a, h16x8 b) { const u32x4 x = __builtin_bit_cast(u32x4, a), y = __builtin_bit_cast(u32x4, b); return (i32x8){(int)x.x, (int)x.y, (int)x.z, (int)x.w, (int)y.x, (int)y.y, (int)y.z, (int)y.w}; }
template <class Epi, bool ALIGN_EPI, bool FP8 = false>
__device__ __forceinline__ void gemm_phase(LAS unsigned char* lds, LAS unsigned char* xl, const Gemm g, const Order& S, const Epi& E) {
    const int tid = threadIdx.x, wid = __builtin_amdgcn_readfirstlane(tid >> 6), lane = tid & 63, wr = wid >> 2, wc = wid & 3, fr = lane & 15, fq = lane >> 4;
    const int K = g.K, nt = K / BK;
    unsigned voffA[2], voffB[2];
#pragma unroll
    for (int i = 0; i < 2; ++i) { int R, C; stage_rc(tid * 16 + i * 8192, R, C); const int Rb = Epi::PERM ? ((R & ~31) + perm32(R & 31)) : R;
        const int Ra = Epi::PERMA ? ((R & ~63) + 4 * (R & 15) + ((R >> 4) & 3)) : R;
        voffA[i] = (unsigned)(Ra * K + C) * 2u; voffB[i] = (unsigned)(Rb * K + C) * 2u; }
    const size_t kstep = (size_t)(BK * 2);
    const size_t hstep = (size_t)HALF * K * 2;
    const size_t tstep = 2 * hstep;
    const size_t rstep = (size_t)K * 2;
    const unsigned ldsw = (unsigned)wid * 1024u;
    const int aoff = lds_byte(wr * 64 + fr, fq * 8), boff = lds_byte(wc * 32 + fr, fq * 8);
#define PG8_SA(b, h) (((b) * 2 + (h)) * HTB)
#define PG8_SB(b, h) ((4 + (b) * 2 + (h)) * HTB)
#define PG8_STAGE(bufoff, gbase, voff) do { _Pragma("unroll") for (int _i = 0; _i < 2; ++_i) \
        __builtin_amdgcn_global_load_lds((const unsigned*)((const char*)(gbase) + (voff)[_i]), (LAS unsigned*)(lds + (bufoff) + ldsw + _i * 8192), 16, 0, 0); } while (0)
#define PG8_LDA(dst, b, h) do { _Pragma("unroll") for (int m = 0; m < 4; ++m) _Pragma("unroll") for (int k = 0; k < 2; ++k) dst[m][k] = *(const LAS h16x8*)(lds + PG8_SA(b, h) + aoff + m * 2048 + k * 1024); } while (0)
#define PG8_LDB(dst, b, h) do { _Pragma("unroll") for (int n = 0; n < 2; ++n) _Pragma("unroll") for (int k = 0; k < 2; ++k) dst[n][k] = *(const LAS h16x8*)(lds + PG8_SB(b, h) + boff + n * 2048 + k * 1024); } while (0)
#define PG8_MMA(ai, bj, At, Bt) do { __builtin_amdgcn_s_setprio(1); _Pragma("unroll") for (int m = 0; m < 4; ++m) _Pragma("unroll") for (int n = 0; n < 2; ++n) { \
        if constexpr (FP8) asm volatile("v_mfma_scale_f32_16x16x128_f8f6f4 %0, %1, %2, %0, %3, %3 op_sel_hi:[0,0,0]" : "+v"(acc[ai][bj][m][n]) : "v"(cat_frag(Bt[n][0], Bt[n][1])), "v"(cat_frag(At[m][0], At[m][1])), "v"(one8)); \
        else { _Pragma("unroll") for (int k = 0; k < 2; ++k) acc[ai][bj][m][n] = __builtin_amdgcn_mfma_f32_16x16x32_f16(Bt[n][k], At[m][k], acc[ai][bj][m][n], 0, 0, 0); } } __builtin_amdgcn_s_setprio(0); } while (0)
#define PG8_WAIT_V(n) asm volatile("s_waitcnt vmcnt(" #n ")" ::: "memory")
#define PG8_WAIT_L(n) asm volatile("s_waitcnt lgkmcnt(" #n ")" ::: "memory")
#define PG8_BAR __builtin_amdgcn_s_barrier()
#define PG8_SCHED __builtin_amdgcn_sched_barrier(0)
    Unit cur, nxt; int ui = 0;
    if (!S.next(0, cur)) return;
    int one8 = 0x7F7F7F7F; asm volatile("" : "+v"(one8));
    f32x4 acc[2][2][4][2];
#pragma unroll
    for (int a = 0; a < 2; ++a)
#pragma unroll
        for (int b = 0; b < 2; ++b)
#pragma unroll
            for (int m = 0; m < 4; ++m)
#pragma unroll
                for (int n = 0; n < 2; ++n) acc[a][b][m][n] = (f32x4){0.f, 0.f, 0.f, 0.f};
    h16x8 At[4][2], B0[2][2], B1[2][2];
    const char* cA = (const char*)g.A + (size_t)S.arow(cur.pm) * rstep; const char* cB = (const char*)g.Bt + (size_t)cur.pn * tstep;
    PG8_STAGE(PG8_SB(0, 0), cB, voffB); PG8_STAGE(PG8_SB(0, 1), cB + hstep, voffB); PG8_STAGE(PG8_SA(0, 0), cA, voffA); PG8_STAGE(PG8_SA(0, 1), cA + hstep, voffA);
    if (wr == 1) PG8_BAR;
    PG8_WAIT_V(2); PG8_BAR;
    PG8_STAGE(PG8_SB(1, 0), cB + kstep, voffB); PG8_STAGE(PG8_SA(1, 0), cA + kstep, voffA); PG8_STAGE(PG8_SB(1, 1), cB + hstep + kstep, voffB);
    PG8_WAIT_V(6); PG8_BAR;
    for (;;) {
        const bool has_next = S.next(ui + 1, nxt);
        E.prefetch(cur, S, xl, ui, wid, lane);
        const char* nA = has_next ? (const char*)g.A + (size_t)S.arow(nxt.pm) * rstep : cA; const char* nB = has_next ? (const char*)g.Bt + (size_t)nxt.pn * tstep : cB;
#pragma unroll 1
        for (int t = 0; t < nt; t += 2) {
            const bool last = (t == nt - 2);
            const char* a1 = cA + (size_t)(t + 1) * kstep;
            const char* a2 = last ? nA : cA + (size_t)(t + 2) * kstep; const char* b2 = last ? nB : cB + (size_t)(t + 2) * kstep;
            const char* a3 = a2 + kstep; const char* b3 = b2 + kstep;
            PG8_LDB(B0, 0, 0); PG8_LDB(B1, 0, 1); PG8_SCHED; PG8_LDA(At, 0, 0); PG8_STAGE(PG8_SA(1, 1), a1 + hstep, voffA);
            PG8_WAIT_V(8); PG8_WAIT_L(0); PG8_BAR; PG8_MMA(0, 0, At, B0); PG8_MMA(0, 1, At, B1); PG8_BAR; PG8_SCHED;
            PG8_LDA(At, 0, 1); PG8_STAGE(PG8_SB(0, 0), b2, voffB); PG8_STAGE(PG8_SB(0, 1), b2 + hstep, voffB); PG8_STAGE(PG8_SA(0, 0), a2, voffA);
            PG8_WAIT_V(8); PG8_WAIT_L(0); PG8_BAR; PG8_MMA(1, 0, At, B0); PG8_MMA(1, 1, At, B1); PG8_BAR; PG8_SCHED;
            PG8_LDB(B0, 1, 0); PG8_LDB(B1, 1, 1); PG8_SCHED; PG8_LDA(At, 1, 0); PG8_STAGE(PG8_SA(0, 1), a2 + hstep, voffA);
            PG8_WAIT_V(8); PG8_WAIT_L(0); PG8_BAR; PG8_MMA(0, 0, At, B0); PG8_MMA(0, 1, At, B1); PG8_BAR; PG8_SCHED;
            PG8_LDA(At, 1, 1); PG8_STAGE(PG8_SB(1, 0), b3, voffB); PG8_STAGE(PG8_SB(1, 1), b3 + hstep, voffB); PG8_STAGE(PG8_SA(1, 0), a3, voffA);
            PG8_WAIT_V(8); PG8_WAIT_L(0); PG8_BAR; PG8_MMA(1, 0, At, B0); PG8_MMA(1, 1, At, B1); PG8_BAR; PG8_SCHED;
        }
        if constexpr (ALIGN_EPI) { if (wr == 0) PG8_BAR; }
        if constexpr (FP8) asm volatile("s_nop 15\n\ts_nop 15" ::: "memory");
        E(acc, cur, S, wr, wc, fr, fq, xl, ui);
        if (!has_next) break;
#pragma unroll
        for (int a = 0; a < 2; ++a)
#pragma unroll
            for (int b = 0; b < 2; ++b)
#pragma unroll
                for (int m = 0; m < 4; ++m)
#pragma unroll
                    for (int n = 0; n < 2; ++n) acc[a][b][m][n] = (f32x4){0.f, 0.f, 0.f, 0.f};
        cur = nxt; cA = nA; cB = nB; ++ui;
        if constexpr (ALIGN_EPI) { if (wr == 1) PG8_BAR; }
    }
    PG8_WAIT_V(0);
    if constexpr (!ALIGN_EPI) { if (wr == 0) PG8_BAR; }
    PG8_BAR;
#undef PG8_SA
#undef PG8_SB
#undef PG8_STAGE
#undef PG8_LDA
#undef PG8_LDB
#undef PG8_MMA
#undef PG8_WAIT_V
#undef PG8_WAIT_L
#undef PG8_BAR
#undef PG8_SCHED
}

struct EpiInA {
    static constexpr bool PERM = true; static constexpr bool PERMA = false;
    f16_t* P; const float* ss_in; float* ssv; bool dry;
    __device__ __forceinline__ void prefetch(const Unit&, const Order&, LAS unsigned char*, int, int, int) const {}
    __device__ __forceinline__ void operator()(f32x4 (&acc)[2][2][4][2], const Unit& u, const Order& S, int wr, int wc, int fr_, int fq_, LAS unsigned char*, int) const {
        int fr = fr_, fq = fq_; asm volatile("" : "+v"(fr), "+v"(fq));
        const int row0 = u.pm * BM + wr * 64 + fr, col0 = u.pn * BM + wc * 32 + 8 * fq;
        const bool act = u.pn < 6, stat = (u.pn >= 3 && u.pn < 6);
#pragma unroll
        for (int ai = 0; ai < 2; ++ai)
#pragma unroll
            for (int m = 0; m < 4; ++m) {
                const int row = row0 + ai * HALF + m * 16;
                const float sc = __builtin_amdgcn_rsqf(ss_in[row] * (1.0f / DM) + EPS);
                float sq = 0.f;
#pragma unroll
                for (int bj = 0; bj < 2; ++bj) {
                    f32x4 v0 = acc[ai][bj][m][0] * sc, v1 = acc[ai][bj][m][1] * sc;
                    if (act) { const f32x2 a0 = gelu_tanh2((f32x2){v0[0], v0[1]}), a1 = gelu_tanh2((f32x2){v0[2], v0[3]}), a2 = gelu_tanh2((f32x2){v1[0], v1[1]}), a3 = gelu_tanh2((f32x2){v1[2], v1[3]});
                        v0 = (f32x4){a0.x, a0.y, a1.x, a1.y}; v1 = (f32x4){a2.x, a2.y, a3.x, a3.y}; }
                    sq += (v0[0] * v0[0] + v0[1] * v0[1]) + (v0[2] * v0[2] + v0[3] * v0[3]) + (v1[0] * v1[0] + v1[1] * v1[1]) + (v1[2] * v1[2] + v1[3] * v1[3]);
                    u32x4 w; w.x = pkh(v0[0], v0[1]); w.y = pkh(v0[2], v0[3]); w.z = pkh(v1[0], v1[1]); w.w = pkh(v1[2], v1[3]);
                    *(u32x4*)(P + (size_t)row * NA + col0 + bj * HALF) = w;
                }
                if (stat && !dry) { sq += __shfl_xor(sq, 16); sq += __shfl_xor(sq, 32); if (fq == 0) atomicAdd(ssv + row, sq); }
            }
    }
};
struct EpiRes {
    static constexpr bool PERM = true; static constexpr bool PERMA = false;
    f16_t* h16; float* out32; float* ss_out; bool dry; unsigned char* h8; float pre;
    __device__ __forceinline__ void prefetch(const Unit&, const Order&, LAS unsigned char*, int, int, int) const {}
    __device__ __forceinline__ void operator()(f32x4 (&acc)[2][2][4][2], const Unit& u, const Order& S, int wr, int wc, int fr_, int fq_, LAS unsigned char*, int) const {
        int fr = fr_, fq = fq_; asm volatile("" : "+v"(fr), "+v"(fq));
        const int row0 = u.pm * BM + wr * 64 + fr, col0 = u.pn * BM + wc * 32 + 8 * fq;
#pragma unroll
        for (int ai = 0; ai < 2; ++ai)
#pragma unroll
            for (int m = 0; m < 4; ++m) {
                const int row = row0 + ai * HALF + m * 16; const size_t off = (size_t)row * DM + col0;
                float sq = 0.f;
#pragma unroll
                for (int bj = 0; bj < 2; ++bj) {
                    const h16x8 bs = *(const h16x8*)(h16 + off + bj * HALF);
                    f32x4 o0 = acc[ai][bj][m][0] * pre, o1 = acc[ai][bj][m][1] * pre;
#pragma unroll
                    for (int e = 0; e < 4; ++e) { o0[e] += (float)bs[e]; o1[e] += (float)bs[4 + e]; }
                    if (out32) { if (!dry) { __builtin_nontemporal_store(o0, (f32x4*)(out32 + off + bj * HALF)); __builtin_nontemporal_store(o1, (f32x4*)(out32 + off + bj * HALF + 4)); } }
                    else if (!dry) {
                        sq += (o0[0] * o0[0] + o0[1] * o0[1]) + (o0[2] * o0[2] + o0[3] * o0[3]) + (o1[0] * o1[0] + o1[1] * o1[1]) + (o1[2] * o1[2] + o1[3] * o1[3]);
                        u32x4 w; w.x = pkh(o0[0], o0[1]); w.y = pkh(o0[2], o0[3]); w.z = pkh(o1[0], o1[1]); w.w = pkh(o1[2], o1[3]);
                        *(u32x4*)(h16 + off + bj * HALF) = w;
                        if (h8) { u32x2 q; q.x = pk8(o0[0] * F8_SA, o0[1] * F8_SA, o0[2] * F8_SA, o0[3] * F8_SA); q.y = pk8(o1[0] * F8_SA, o1[1] * F8_SA, o1[2] * F8_SA, o1[3] * F8_SA); *(u32x2*)(h8 + off + bj * HALF) = q; } }
                }
                if (!out32 && !dry) { sq += __shfl_xor(sq, 16); sq += __shfl_xor(sq, 32); if (fq == 0) atomicAdd(ss_out + row, sq); }
            }
    }
};
__device__ __forceinline__ float dpp_ror1(float v) { return __builtin_bit_cast(float, __builtin_amdgcn_mov_dpp(__builtin_bit_cast(int, v), 0x121, 0xf, 0xf, false)); }
__device__ __forceinline__ float dpp_ror2(float v) { return __builtin_bit_cast(float, __builtin_amdgcn_mov_dpp(__builtin_bit_cast(int, v), 0x122, 0xf, 0xf, false)); }
__device__ __forceinline__ float dpp_shr1_keep(float keep, float v) { return __builtin_bit_cast(float, __builtin_amdgcn_update_dpp(__builtin_bit_cast(int, keep), __builtin_bit_cast(int, v), 0x111, 0xf, 0xf, false)); }
__device__ __forceinline__ float dpp_shr2_keep(float keep, float v) { return __builtin_bit_cast(float, __builtin_amdgcn_update_dpp(__builtin_bit_cast(int, keep), __builtin_bit_cast(int, v), 0x112, 0xf, 0xf, false)); }
struct EpiUp {
    static constexpr bool PERM = false;
    static constexpr bool PERMA = true;
    f16_t* U; const float* ss_in; const float* cw; const float* cb; float* bnd_g;
    __device__ __forceinline__ void prefetch(const Unit& u, const Order& S, LAS unsigned char* xl, int ui, int wid, int lane) const {
        if (wid >= 5) return;
        LAS unsigned char* dst = xl + 8192 + (ui & 1) * 5120 + wid * 1024;
        const float* src;
        if (wid < 3) src = cw + (size_t)wid * FF2 + (lane >> 5) * FF + u.pn * HALF + 4 * (lane & 31);
        else if (wid == 3) src = cb + (lane >> 5) * FF + u.pn * HALF + 4 * (lane & 31);
        else src = ss_in + S.arow(u.pm) + 4 * lane;
        __builtin_amdgcn_global_load_lds((const unsigned*)src, (LAS unsigned*)dst, 16, 0, 0);
    }
    __device__ __forceinline__ void operator()(f32x4 (&acc)[2][2][4][2], const Unit& u, const Order& S, int wr, int wc, int fr_, int fq_, LAS unsigned char* xl, int ui) const {
        int fr = fr_, fq = fq_; asm volatile("" : "+v"(fr), "+v"(fq));
        const int rs = S.arow(u.pm), lo = 2;
        const int trow0 = wr * 64 + 4 * fr;
        LAS const float* cst = (LAS const float*)(xl + 8192 + (ui & 1) * 5120);
#pragma unroll
        for (int ai = 0; ai < 2; ++ai) {
            const f32x4 ss4 = *(const LAS f32x4*)(cst + 1024 + trow0 + ai * HALF);
#pragma unroll
            for (int m = 0; m < 4; ++m) {
                const float sc = __builtin_amdgcn_rsqf(ss4[m] * (1.0f / DM) + EPS);
#pragma unroll
                for (int bj = 0; bj < 2; ++bj)
#pragma unroll
                    for (int n = 0; n < 2; ++n) acc[ai][bj][m][n] *= sc;
            }
        }
        LAS float* bnd = (LAS float*)xl;
        const int tcol = wc * 32 + 4 * fq;
        if (fr == 15) {
#pragma unroll
            for (int ai = 0; ai < 2; ++ai)
#pragma unroll
                for (int bj = 0; bj < 2; ++bj)
#pragma unroll
                    for (int n = 0; n < 2; ++n) { *(LAS f32x4*)(bnd + ((2 * ai + wr) * 2 + 0) * 256 + bj * HALF + tcol + 16 * n) = acc[ai][bj][2][n]; *(LAS f32x4*)(bnd + ((2 * ai + wr) * 2 + 1) * 256 + bj * HALF + tcol + 16 * n) = acc[ai][bj][3][n]; }
        }
        { float* bq = bnd_g + (size_t)(u.pm * S.nN + u.pn) * 1024 + tcol;
          if (wr == 0 && fr == 0) {
#pragma unroll
              for (int bj = 0; bj < 2; ++bj)
#pragma unroll
                  for (int n = 0; n < 2; ++n) { *(f32x4*)(bq + 0 * 256 + bj * HALF + 16 * n) = acc[0][bj][0][n]; *(f32x4*)(bq + 1 * 256 + bj * HALF + 16 * n) = acc[0][bj][1][n]; } }
          if (wr == 1 && fr == 15) {
#pragma unroll
              for (int bj = 0; bj < 2; ++bj)
#pragma unroll
                  for (int n = 0; n < 2; ++n) { *(f32x4*)(bq + 2 * 256 + bj * HALF + 16 * n) = acc[1][bj][2][n]; *(f32x4*)(bq + 3 * 256 + bj * HALF + 16 * n) = acc[1][bj][3][n]; } } }
        LDS_WAIT(); __builtin_amdgcn_s_barrier(); asm volatile("" ::: "memory");
#pragma unroll
        for (int n = 0; n < 2; ++n) {
            f32x4 w0[2], w1[2], w2[2], bb[2];
#pragma unroll
            for (int bj = 0; bj < 2; ++bj) { const int cc = bj * HALF + tcol + 16 * n;
                w0[bj] = *(const LAS f32x4*)(cst + cc); w1[bj] = *(const LAS f32x4*)(cst + 256 + cc); w2[bj] = *(const LAS f32x4*)(cst + 512 + cc); bb[bj] = *(const LAS f32x4*)(cst + 768 + cc); }
#pragma unroll
            for (int ai = 0; ai < 2; ++ai) {
                const int g = 2 * ai + wr;
                f32x4 h[4][2];
#pragma unroll
                for (int bj = 0; bj < 2; ++bj) {
                    f32x4 r63 = {0.f, 0.f, 0.f, 0.f}, r62 = r63;
                    if (g > 0) { r62 = *(const LAS f32x4*)(bnd + ((g - 1) * 2 + 0) * 256 + bj * HALF + tcol + 16 * n); r63 = *(const LAS f32x4*)(bnd + ((g - 1) * 2 + 1) * 256 + bj * HALF + tcol + 16 * n); }
                    const f32x4 x0 = acc[ai][bj][0][n], x1 = acc[ai][bj][1][n], x2 = acc[ai][bj][2][n], x3 = acc[ai][bj][3][n];
                    f32x4 pm1, pm2;
#pragma unroll
                    for (int e = 0; e < 4; ++e) { pm1[e] = dpp_shr1_keep(r63[e], x3[e]); pm2[e] = dpp_shr1_keep(r62[e], x2[e]); }
                    h[0][bj] = __builtin_elementwise_fma(w0[bj], pm2, __builtin_elementwise_fma(w1[bj], pm1, __builtin_elementwise_fma(w2[bj], x0, bb[bj])));
                    h[1][bj] = __builtin_elementwise_fma(w0[bj], pm1, __builtin_elementwise_fma(w1[bj], x0, __builtin_elementwise_fma(w2[bj], x1, bb[bj])));
                    h[2][bj] = __builtin_elementwise_fma(w0[bj], x0, __builtin_elementwise_fma(w1[bj], x1, __builtin_elementwise_fma(w2[bj], x2, bb[bj])));
                    h[3][bj] = __builtin_elementwise_fma(w0[bj], x1, __builtin_elementwise_fma(w1[bj], x2, __builtin_elementwise_fma(w2[bj], x3, bb[bj])));
                }
#pragma unroll
                for (int m = 0; m < 4; ++m) {
                    f32x4 o; { const f32x2 g0 = gelu_tanh2((f32x2){h[m][0][0], h[m][0][1]}) * (f32x2){h[m][1][0], h[m][1][1]}, g1 = gelu_tanh2((f32x2){h[m][0][2], h[m][0][3]}) * (f32x2){h[m][1][2], h[m][1][3]}; o = (f32x4){g0.x, g0.y, g1.x, g1.y}; }
                    const int trow = trow0 + ai * HALF + m;
                    if (trow >= lo) { u32x2 pk; pk.x = pkh(o[0], o[1]); pk.y = pkh(o[2], o[3]); *(u32x2*)(U + (size_t)(rs + trow) * FF + u.pn * HALF + tcol + 16 * n) = pk; }
                }
            }
        }
    }
};
struct EpiInB {
    static constexpr bool PERM = true; static constexpr bool PERMA = false;
    f16_t* P; const float* ss_in; const float* gq; const float* gk; float* kmean; bool dry; float pre;
    __device__ __forceinline__ void prefetch(const Unit&, const Order&, LAS unsigned char*, int, int, int) const {}
    __device__ __forceinline__ void operator()(f32x4 (&acc)[2][2][4][2], const Unit& u, const Order& S, int wr, int wc, int fr_, int fq_, LAS unsigned char*, int) const {
        int fr = fr_, fq = fq_; asm volatile("" : "+v"(fr), "+v"(fq));
        const int row0 = u.pm * BM + wr * 64 + fr, colh = u.pn * BM + wc * 64;
        const bool nrm = u.pn < 6, isk = (u.pn >= 3 && u.pn < 6);
        f32x4 gv[2][2];
#pragma unroll
        for (int bj = 0; bj < 2; ++bj)
#pragma unroll
            for (int n = 0; n < 2; ++n) gv[bj][n] = nrm ? *(const f32x4*)((isk ? gk : gq) + 32 * bj + 8 * fq + 4 * n) : (f32x4){1.f, 1.f, 1.f, 1.f};
        f32x4 ks[2][2];
#pragma unroll
        for (int bj = 0; bj < 2; ++bj)
#pragma unroll
            for (int n = 0; n < 2; ++n) ks[bj][n] = (f32x4){0.f, 0.f, 0.f, 0.f};
#pragma unroll
        for (int ai = 0; ai < 2; ++ai)
#pragma unroll
            for (int m = 0; m < 4; ++m) {
                const int row = row0 + ai * HALF + m * 16;
                const float sc = __builtin_amdgcn_rsqf(ss_in[row] * (1.0f / DM) + EPS) * pre;
                f32x4 v[2][2]; float sq = 0.f;
#pragma unroll
                for (int bj = 0; bj < 2; ++bj)
#pragma unroll
                    for (int n = 0; n < 2; ++n) { v[bj][n] = acc[ai][bj][m][n] * sc; const f32x4 t = v[bj][n]; sq += (t[0] * t[0] + t[1] * t[1]) + (t[2] * t[2] + t[3] * t[3]); }
                float rn = 1.f;
                if (nrm) { sq += __shfl_xor(sq, 16); sq += __shfl_xor(sq, 32); rn = __builtin_amdgcn_rsqf(sq * (1.0f / HD) + EPS); }
#pragma unroll
                for (int bj = 0; bj < 2; ++bj) {
                    const f32x4 a = v[bj][0] * rn * gv[bj][0], b = v[bj][1] * rn * gv[bj][1];
                    ks[bj][0] += a; ks[bj][1] += b;
                    u32x4 w; w.x = pkh(a[0], a[1]); w.y = pkh(a[2], a[3]); w.z = pkh(b[0], b[1]); w.w = pkh(b[2], b[3]);
                    *(u32x4*)(P + (size_t)row * NB + colh + 32 * bj + 8 * fq) = w;
                }
            }
        if (isk && !dry) {
            const int b = u.pm / NBLK, blk = u.pm % NBLK, h = (u.pn - 3) * 4 + wc;
            float* dst = kmean + ((size_t)(b * MOBA_H + h) * NBLK + blk) * HD;
#pragma unroll
            for (int bj = 0; bj < 2; ++bj)
#pragma unroll
                for (int n = 0; n < 2; ++n)
#pragma unroll
                    for (int e = 0; e < 4; ++e) {
                        float s = ks[bj][n][e];
                        s += __shfl_xor(s, 1); s += __shfl_xor(s, 2); s += __shfl_xor(s, 4); s += __shfl_xor(s, 8);
                        if (fr == 0) atomicAdd(dst + 32 * bj + 8 * fq + 4 * n + e, s);
                    }
        }
    }
};
struct EpiKV {
    static constexpr bool PERM = true; static constexpr bool PERMA = false;
    f16_t* KM; f16_t* VM; const float* ss_in; const float* gkm;
    __device__ __forceinline__ void prefetch(const Unit&, const Order&, LAS unsigned char*, int, int, int) const {}
    __device__ __forceinline__ void operator()(f32x4 (&acc)[2][2][4][2], const Unit& u, const Order& S, int wr, int wc, int fr_, int fq_, LAS unsigned char*, int) const {
        int fr = fr_, fq = fq_; asm volatile("" : "+v"(fr), "+v"(fq));
        const bool isk = (u.pn == 0);
        f16_t* dst = (isk ? KM : VM) + (size_t)(u.pm * 4 + wc) * NMEM * HD;
        f32x4 gv[2][2];
#pragma unroll
        for (int bj = 0; bj < 2; ++bj)
#pragma unroll
            for (int n = 0; n < 2; ++n) gv[bj][n] = isk ? *(const f32x4*)(gkm + 32 * bj + 8 * fq + 4 * n) : (f32x4){1.f, 1.f, 1.f, 1.f};
#pragma unroll
        for (int ai = 0; ai < 2; ++ai)
#pragma unroll
            for (int m = 0; m < 4; ++m) {
                const int key = ai * HALF + wr * 64 + m * 16 + fr;
                const float sc = __builtin_amdgcn_rsqf(ss_in[u.pm * BM + key] * (1.0f / DM) + EPS);
                f32x4 v[2][2]; float sq = 0.f;
#pragma unroll
                for (int bj = 0; bj < 2; ++bj)
#pragma unroll
                    for (int n = 0; n < 2; ++n) { v[bj][n] = acc[ai][bj][m][n] * sc; const f32x4 t = v[bj][n]; sq += (t[0] * t[0] + t[1] * t[1]) + (t[2] * t[2] + t[3] * t[3]); }
                float rn = 1.f;
                if (isk) { sq += __shfl_xor(sq, 16); sq += __shfl_xor(sq, 32); rn = __builtin_amdgcn_rsqf(sq * (1.0f / HD) + EPS); }
#pragma unroll
                for (int bj = 0; bj < 2; ++bj) {
                    const f32x4 a = v[bj][0] * rn * gv[bj][0], b = v[bj][1] * rn * gv[bj][1];
                    u32x4 w; w.x = pkh(a[0], a[1]); w.y = pkh(a[2], a[3]); w.z = pkh(b[0], b[1]); w.w = pkh(b[2], b[3]);
                    *(u32x4*)(dst + (size_t)key * HD + 32 * bj + 8 * fq) = w;
                }
            }
    }
};
struct EpiNull {
    static constexpr bool PERM = true; static constexpr bool PERMA = false;
    __device__ __forceinline__ void prefetch(const Unit&, const Order&, LAS unsigned char*, int, int, int) const {}
    __device__ __forceinline__ void operator()(f32x4 (&acc)[2][2][4][2], const Unit& u, const Order& S, int wr, int wc, int fr_, int fq_, LAS unsigned char*, int) const {
#pragma unroll
        for (int ai = 0; ai < 2; ++ai)
#pragma unroll
            for (int bj = 0; bj < 2; ++bj)
#pragma unroll
                for (int m = 0; m < 4; ++m)
#pragma unroll
                    for (int n = 0; n < 2; ++n) asm volatile("" :: "v"(acc[ai][bj][m][n]));
    }
};
}

#define XB_TMO      128
#define XB_XCNT(j)  (256  + 64 * (j))
#define XB_XSUB(j)  (1280 + 64 * (j))
#define XB_XGEN(j)  (2304 + 64 * (j))
#define XB_TOP      3328
#define XB_TOPGEN   3392
#define XCD_BAR_WORDS 3456
#define XB_SPIN_CAP (1u << 18)
__device__ __forceinline__ unsigned xb_ld(unsigned* p)              { return __hip_atomic_load(p, __ATOMIC_RELAXED, __HIP_MEMORY_SCOPE_AGENT); }
__device__ __forceinline__ unsigned xb_add(unsigned* p, unsigned v) { return __hip_atomic_fetch_add(p, v, __ATOMIC_RELAXED, __HIP_MEMORY_SCOPE_AGENT); }
__device__ __forceinline__ unsigned xb_xcc_id() { return (unsigned)__builtin_amdgcn_s_getreg((3 << 11) | 20) & 0xFu; }
#define XB_SPIN(cond, bar) do { unsigned _sp = 0; while (cond) { __builtin_amdgcn_s_sleep(1); \
    if ((++_sp & 255u) == 0u) { if (xb_ld(&(bar)[XB_TMO])) break; if (_sp > XB_SPIN_CAP) { atomicAdd(&(bar)[XB_TMO], 1u); break; } } } } while (0)
struct XcdBarrier { unsigned* bar; unsigned x; volatile LAS unsigned* st; };
__device__ __forceinline__ XcdBarrier xcd_barrier_post(unsigned* bar, volatile LAS unsigned* st) {
    XcdBarrier b; b.bar = bar; b.x = xb_xcc_id(); b.st = st;
    if (threadIdx.x == 0) (void)xb_add(&bar[XB_XCNT(b.x)], 1u);
    return b;
}
__device__ __forceinline__ void xcd_barrier_complete(unsigned* bar, unsigned x, unsigned& nloc, unsigned& nx) {
    const unsigned G = gridDim.x * gridDim.y * gridDim.z;
    unsigned sum, cnt, mine, sp = 0u;
    for (;;) {
        sum = 0u; cnt = 0u; mine = 0u;
#pragma unroll
        for (unsigned j = 0; j < 16; ++j) { const unsigned c = xb_ld(&bar[XB_XCNT(j)]); sum += c; cnt += (c > 0u) ? 1u : 0u; mine = (j == x) ? c : mine; }
        if (sum == G) break;
        __builtin_amdgcn_s_sleep(1);
        if ((++sp & 255u) == 0u) { if (xb_ld(&bar[XB_TMO])) break; if (sp > XB_SPIN_CAP) { atomicAdd(&bar[XB_TMO], 1u); break; } }
    }
    nloc = mine > 0u ? mine : 1u; nx = cnt > 0u ? cnt : 1u;
}
__device__ __forceinline__ void xcd_barrier(const XcdBarrier& b) {
    asm volatile("s_waitcnt vmcnt(0)" ::: "memory");
    __syncthreads();
    if (threadIdx.x == 0) {
        unsigned* bar = b.bar;
        __builtin_amdgcn_s_waitcnt(0);
        unsigned nloc = b.st[0], nx = b.st[1];
        if (nloc == 0u) { xcd_barrier_complete(bar, b.x, nloc, nx); b.st[0] = nloc; b.st[1] = nx; }
        const unsigned old = xb_add(&bar[XB_XSUB(b.x)], 1u);
        const unsigned gen = old / nloc;
        if (old + 1u == (gen + 1u) * nloc) {
            __builtin_amdgcn_fence(__ATOMIC_RELEASE, "agent");
            asm volatile("s_waitcnt vmcnt(0)" ::: "memory");
            const unsigned og = xb_add(&bar[XB_TOP], 1u);
            const unsigned tg = og / nx;
            if (og + 1u == (tg + 1u) * nx) xb_add(&bar[XB_TOPGEN], 1u);
            else XB_SPIN(xb_ld(&bar[XB_TOPGEN]) == tg, bar);
            __builtin_amdgcn_fence(__ATOMIC_ACQUIRE, "agent");
            xb_add(&bar[XB_XGEN(b.x)], 1u);
            asm volatile("s_waitcnt vmcnt(0)" ::: "memory");
        } else {
            XB_SPIN(xb_ld(&bar[XB_XGEN(b.x)]) == gen, bar);
            __builtin_amdgcn_fence(__ATOMIC_ACQUIRE, "agent");
            asm volatile("s_waitcnt vmcnt(0)" ::: "memory");
        }
    }
    __syncthreads();
}

struct Args { const float* in[21]; float* out; unsigned char* ws; int ph_lo, ph_hi; };
struct Frame {
    LAS unsigned char* lds; volatile LAS unsigned* MISC; gu32* ctl;
    int tid, lane, wave, vcu, G;
};

template <bool FP8>
__device__ __forceinline__ void p0_transpose_item(const float* W, int K, int N, f16_t* WT, const float* gain, LAS float* scr, int k0, int n0, int dst0, int lane) {
    { f32x4 v[8];
#pragma unroll
        for (int i = 0; i < 8; ++i) v[i] = __builtin_nontemporal_load((const f32x4*)(W + (size_t)(k0 + (lane >> 3) + 8 * i) * N + n0 + 4 * (lane & 7)));
#pragma unroll
        for (int i = 0; i < 8; ++i) { const int kk = (lane >> 3) + 8 * i; const float gsc = (gain ? gain[k0 + kk] : 1.0f) * (FP8 ? F8_SW : 1.0f);
#pragma unroll
            for (int e = 0; e < 4; ++e) scr[kk * 33 + 4 * (lane & 7) + e] = v[i][e] * gsc; } }
    LDS_WAIT(); asm volatile("" ::: "memory");
    const int c = lane & 7;
#pragma unroll
    for (int j = 0; j < 4; ++j) { const int n = (lane >> 3) + 8 * j; const LAS float* s = scr + (8 * c) * 33 + n;
        if constexpr (FP8) { u32x2 o; o.x = pk8(s[0 * 33], s[1 * 33], s[2 * 33], s[3 * 33]); o.y = pk8(s[4 * 33], s[5 * 33], s[6 * 33], s[7 * 33]);
            *(GAS u32x2*)((unsigned char*)WT + (size_t)(dst0 + n) * K + k0 + 8 * c) = o; }
        else { u32x4 o; o.x = pkh(s[0 * 33], s[1 * 33]); o.y = pkh(s[2 * 33], s[3 * 33]); o.z = pkh(s[4 * 33], s[5 * 33]); o.w = pkh(s[6 * 33], s[7 * 33]);
            *(GAS u32x4*)(WT + (size_t)(dst0 + n) * K + k0 + 8 * c) = o; } }
    LDS_WAIT(); asm volatile("" ::: "memory");
}
__device__ __forceinline__ int map_ident(int n0) { return n0; }
__device__ __forceinline__ int map_heads(int n0) { const int t = n0 >> 8, l = n0 & 255, wc = l >> 6, bj = (l >> 5) & 1; return (t << 8) + 128 * bj + 32 * wc; }
__device__ __forceinline__ int map_up(int n0) { const int bj = n0 >= FF ? 1 : 0, j = n0 - bj * FF; return 256 * (j >> 7) + 128 * bj + (j & 127); }

template <int MAP, bool FP8 = false>
__device__ __forceinline__ void p0_matrix(const Frame& F, const float* W, int K, int N, f16_t* WT, const float* gain, int& base, int gw, int NGW, LAS float* scr) {
    const int nblk = N / 32, items = (K / 64) * nblk;
    int first = gw - (base % NGW); if (first < 0) first += NGW;
    for (int it = first; it < items; it += NGW) {
        const int kb = it / nblk, nb = it % nblk, n0 = 32 * nb;
        const int d0 = (MAP == 0) ? map_ident(n0) : (MAP == 1) ? map_heads(n0) : map_up(n0);
        p0_transpose_item<FP8>(W, K, N, WT, gain, scr, 64 * kb, n0, d0, F.lane);
    }
    base += items;
}

__device__ __forceinline__ void p0_late_weights(const Frame& F, const Args& a, int gw, int NGW) {
    unsigned char* ws = a.ws;
    LAS float* scr = (LAS float*)(F.lds + F.wave * 16384);
    int base = 0;
    p0_matrix<0>(F, a.in[5], DM, DM, (f16_t*)(ws + WS_WOUTA), nullptr, base, gw, NGW, scr);
    p0_matrix<2>(F, a.in[17], DM, FF2, (f16_t*)(ws + WS_WUP0), a.in[3], base, gw, NGW, scr);
    p0_matrix<0>(F, a.in[20], FF, DM, (f16_t*)(ws + WS_WDN0), nullptr, base, gw, NGW, scr);
}
__device__ __forceinline__ void p0_prologue(const Frame& F, const Args& a) {
    unsigned char* ws = a.ws;
    LAS float* scr = (LAS float*)(F.lds + F.wave * 16384);
    const int gw = F.vcu * NWAVES + F.wave, NGW = F.G * NWAVES;
    int base = 0;
    p0_matrix<0>(F, a.in[4], DM, NA, (f16_t*)(ws + WS_WINA), a.in[2], base, gw, NGW, scr);
    p0_matrix<1, true>(F, a.in[9], DM, NB, (f16_t*)(ws + WS_WINB), a.in[2] + DM, base, gw, NGW, scr);
    p0_matrix<0, true>(F, a.in[10], DM, DM, (f16_t*)(ws + WS_WOUTB), nullptr, base, gw, NGW, scr);
    p0_matrix<2>(F, a.in[17] + (size_t)DM * FF2, DM, FF2, (f16_t*)(ws + WS_WUP1), a.in[3] + DM, base, gw, NGW, scr);
    p0_matrix<0>(F, a.in[20] + (size_t)FF * DM, FF, DM, (f16_t*)(ws + WS_WDN1), nullptr, base, gw, NGW, scr);
    p0_matrix<1>(F, a.in[14], DM, 2 * MEMW, (f16_t*)(ws + WS_WKV), a.in[13], base, gw, NGW, scr);
    for (int ci = F.vcu * 512 + F.tid; ci < NGRP * CHUNK * 16; ci += F.G * 512) { const int g = ci / (CHUNK * 16), t = (ci >> 4) & (CHUNK - 1), c = ci & 15;
        const float* src = a.in[7] + (size_t)g * CHUNK * CHUNK + t * CHUNK + 8 * c; u32x4 o = {0u, 0u, 0u, 0u};
        if (8 * c <= t) { const f32x4 x0 = *(const f32x4*)src, x1 = *(const f32x4*)(src + 4); float v[8] = {x0[0], x0[1], x0[2], x0[3], x1[0], x1[1], x1[2], x1[3]};
#pragma unroll
            for (int j = 0; j < 8; ++j) v[j] = (8 * c + j <= t) ? v[j] : 0.f;
            o.x = pkh(v[0], v[1]); o.y = pkh(v[2], v[3]); o.z = pkh(v[4], v[5]); o.w = pkh(v[6], v[7]); }
        *(u32x4*)(ws + WS_W16S + (size_t)g * 32768 + t * 256 + ((c ^ (t & 15)) << 4)) = o; }
    {
        const float* x = a.in[0]; f16_t* A16 = (f16_t*)(ws + WS_A16); float* ss0 = (float*)(F.ctl + CW_SS0);
        for (int m0 = gw; m0 < M; m0 += 4 * NGW) {
            f32x4 v[4][4];
#pragma unroll
            for (int r = 0; r < 4; ++r) { const int mm = (m0 + r * NGW < M) ? m0 + r * NGW : m0; const GAS f32x4* xr = (const GAS f32x4*)(x + (size_t)mm * DM) + F.lane;
#pragma unroll
                for (int j = 0; j < 4; ++j) v[r][j] = __builtin_nontemporal_load(xr + 64 * j); }
#pragma unroll
            for (int r = 0; r < 4; ++r) { const int m = m0 + r * NGW; if (m >= M) break; float s = 0.f;
#pragma unroll
                for (int j = 0; j < 4; ++j) s += (v[r][j].x * v[r][j].x + v[r][j].y * v[r][j].y) + (v[r][j].z * v[r][j].z + v[r][j].w * v[r][j].w);
                s = wave_sum(s);
                if (F.lane == 0) ss0[m] = s;
                GAS u32x2* o8 = (GAS u32x2*)(A16 + (size_t)m * DM) + F.lane;
#pragma unroll
                for (int j = 0; j < 4; ++j) { u32x2 w; w.x = pkh(v[r][j].x, v[r][j].y); w.y = pkh(v[r][j].z, v[r][j].w); o8[64 * j] = w; } }
        }
    }
    {
        const float* x = a.in[1]; f16_t* X16 = (f16_t*)(ws + WS_MEM16); float* ssm = (float*)(F.ctl + CW_SSM);
        for (int m = gw; m < BATCH * NMEM; m += NGW) {
            const GAS f32x4* xr = (const GAS f32x4*)(x + (size_t)m * DM) + F.lane;
            f32x4 v[4]; float s = 0.f;
#pragma unroll
            for (int j = 0; j < 4; ++j) { v[j] = xr[64 * j]; s += (v[j].x * v[j].x + v[j].y * v[j].y) + (v[j].z * v[j].z + v[j].w * v[j].w); }
            s = wave_sum(s);
            if (F.lane == 0) ssm[m] = s;
            GAS u32x2* o8 = (GAS u32x2*)(X16 + (size_t)m * DM) + F.lane;
#pragma unroll
            for (int j = 0; j < 4; ++j) { u32x2 w; w.x = pkh(v[j].x, v[j].y); w.y = pkh(v[j].z, v[j].w); o8[64 * j] = w; }
        }
    }
}

typedef short v4i16_t __attribute__((ext_vector_type(4)));
__device__ __forceinline__ h16x4 vtr(LAS const unsigned char* p) { return __builtin_bit_cast(h16x4, __builtin_amdgcn_ds_read_tr16_b64_v4i16((LAS v4i16_t*)p)); }
__device__ __forceinline__ h16x8 cat8(h16x4 lo, h16x4 hi) { return (h16x8){lo[0], lo[1], lo[2], lo[3], hi[0], hi[1], hi[2], hi[3]}; }
__device__ __forceinline__ u32x4 pair16(u32x2 a, u32x2 b) {
    const auto r0 = __builtin_amdgcn_permlane16_swap(a.x, b.x, false, false), r1 = __builtin_amdgcn_permlane16_swap(a.y, b.y, false, false);
    return (u32x4){r0[0], r1[0], r0[1], r1[1]};
}
__device__ __forceinline__ void unpair16(u32x4 v, u32x2& a, u32x2& b) {
    const auto r0 = __builtin_amdgcn_permlane16_swap(v.x, v.z, false, false), r1 = __builtin_amdgcn_permlane16_swap(v.y, v.w, false, false);
    a = (u32x2){r0[0], r1[0]}; b = (u32x2){r0[1], r1[1]};
}
__device__ __forceinline__ int pair16_dim(int G, int dt0) { return (G & 1) ? 16 * (dt0 + 1) + 4 * (G - 1) : 16 * dt0 + 4 * G; }
__device__ __forceinline__ void store_o16(f16_t* rowp, const f32x4 (&o)[4], float il, int G) {
#pragma unroll
    for (int pr = 0; pr < 2; ++pr) { const int dt0 = 2 * pr;
        u32x2 a, b; a.x = pkh(o[dt0][0] * il, o[dt0][1] * il); a.y = pkh(o[dt0][2] * il, o[dt0][3] * il); b.x = pkh(o[dt0 + 1][0] * il, o[dt0 + 1][1] * il); b.y = pkh(o[dt0 + 1][2] * il, o[dt0 + 1][3] * il);
        *(u32x4*)(rowp + pair16_dim(G, dt0)) = pair16(a, b); }
}
__device__ __forceinline__ void store_o8(unsigned char* rowp, const f32x4 (&o)[4], float il, int G) {
    const float c = il * F8_SY;
#pragma unroll
    for (int pr = 0; pr < 2; ++pr) { const int dt0 = 2 * pr;
        const unsigned a = pk8(o[dt0][0] * c, o[dt0][1] * c, o[dt0][2] * c, o[dt0][3] * c), b = pk8(o[dt0 + 1][0] * c, o[dt0 + 1][1] * c, o[dt0 + 1][2] * c, o[dt0 + 1][3] * c);
        const auto r = __builtin_amdgcn_permlane16_swap(a, b, false, false);
        *(u32x2*)(rowp + pair16_dim(G, dt0)) = (u32x2){r[0], r[1]}; }
}
constexpr float LOG2E = 1.4426950408889634f;
constexpr float BOUND_SHIFT = 4.0f;

__device__ __forceinline__ void stage_k_img(LAS unsigned char* img, const f16_t* src, int pitch, int nrows, int tid) {
    for (int ci = tid; ci < nrows * 8; ci += 512) { const int r = ci >> 3, c = ci & 7;
        const u32x4 v = *(const u32x4*)(src + (size_t)r * pitch + 8 * c);
        *(LAS u32x4*)(img + r * 128 + ((c ^ (r & 7)) << 4)) = v; }
}
__device__ __forceinline__ void stage_v_img(LAS unsigned char* img, const f16_t* src, int pitch, int nrows, int tid) {
    for (int ci = tid; ci < nrows * 8; ci += 512) { const int r = ci >> 3, c = ci & 7;
        const u32x4 v = *(const u32x4*)(src + (size_t)r * pitch + 8 * c);
        *(LAS u32x4*)(img + r * 128 + ((((c >> 1) ^ ((r >> 1) & 3))) << 5) + ((c & 1) << 4)) = v; }
}
__device__ __forceinline__ void glds16_asm(const void* gsrc, unsigned lds_dst) { unsigned keep;
    asm volatile("s_mov_b32 %0, m0\n\ts_mov_b32 m0, %2\n\ts_nop 0\n\tglobal_load_lds_dwordx4 %1, off\n\ts_mov_b32 m0, %0" : "=&s"(keep) : "v"(gsrc), "s"(lds_dst) : "memory"); }
__device__ __forceinline__ void dma_kv_imgs(LAS unsigned char* Kimg, LAS unsigned char* Vimg, const f16_t* ksrc, const f16_t* vsrc, int wave, int lane, int pitch = NB) {
    const int rl = lane >> 3, pos = lane & 7;
    const int kc = pos ^ rl, vc = 2 * ((pos >> 1) ^ ((lane >> 4) & 3)) + (pos & 1);
    const unsigned kd = (unsigned)__builtin_amdgcn_readfirstlane((int)(unsigned)(uintptr_t)Kimg), vd = (unsigned)__builtin_amdgcn_readfirstlane((int)(unsigned)(uintptr_t)Vimg);
#pragma unroll
    for (int i = 0; i < 4; ++i) { const int pc = wave + 8 * i, row = 8 * pc + rl;
        glds16_asm(ksrc + (size_t)row * pitch + 8 * kc, (unsigned)__builtin_amdgcn_readfirstlane((int)(kd + pc * 1024)));
        glds16_asm(vsrc + (size_t)row * pitch + 8 * vc, (unsigned)__builtin_amdgcn_readfirstlane((int)(vd + pc * 1024))); }
}
template <bool CAUSAL>
__device__ __forceinline__ void attn_tile(LAS const unsigned char* Kimg, LAS const unsigned char* Vimg, int nsteps, h16x8 q0, h16x8 q1, float mb, int qrel, f32x4 (&o)[4], float& lsum, int lane) {
    const int fr = lane & 15, G = lane >> 4, qq = fr >> 2, p = fr & 3;
    const int kof0 = fr * 128 + (((0 + G) ^ (fr & 7)) << 4), kof1 = fr * 128 + (((4 + G) ^ (fr & 7)) << 4);
    const int vrow = (4 * G + qq) * 128 + p * 8, sw = (2 * G + (qq >> 1)) & 3;
    for (int ks = 0; ks < nsteps; ++ks) {
        LAS const unsigned char* kb = Kimg + ks * 4096;
        const h16x8 a00 = *(LAS const h16x8*)(kb + kof0), a01 = *(LAS const h16x8*)(kb + kof1);
        const h16x8 a10 = *(LAS const h16x8*)(kb + 2048 + kof0), a11 = *(LAS const h16x8*)(kb + 2048 + kof1);
        f32x4 s0 = {0.f, 0.f, 0.f, 0.f}, s1 = {0.f, 0.f, 0.f, 0.f};
        s0 = __builtin_amdgcn_mfma_f32_16x16x32_f16(a00, q0, s0, 0, 0, 0); s0 = __builtin_amdgcn_mfma_f32_16x16x32_f16(a01, q1, s0, 0, 0, 0);
        s1 = __builtin_amdgcn_mfma_f32_16x16x32_f16(a10, q0, s1, 0, 0, 0); s1 = __builtin_amdgcn_mfma_f32_16x16x32_f16(a11, q1, s1, 0, 0, 0);
        f32x4 p0, p1;
#pragma unroll
        for (int e = 0; e < 4; ++e) { p0[e] = __builtin_amdgcn_exp2f(s0[e] - mb); p1[e] = __builtin_amdgcn_exp2f(s1[e] - mb); }
        if (CAUSAL) { const int kr = ks * 32 + 4 * G;
#pragma unroll
            for (int e = 0; e < 4; ++e) { if (kr + e > qrel) p0[e] = 0.f; if (kr + 16 + e > qrel) p1[e] = 0.f; } }
        lsum += ((p0[0] + p0[1]) + (p0[2] + p0[3])) + ((p1[0] + p1[1]) + (p1[2] + p1[3]));
        u32x4 pw; pw.x = pkh(p0[0], p0[1]); pw.y = pkh(p0[2], p0[3]); pw.z = pkh(p1[0], p1[1]); pw.w = pkh(p1[2], p1[3]);
        const h16x8 pf = __builtin_bit_cast(h16x8, pw);
        LAS const unsigned char* vb = Vimg + ks * 4096 + vrow;
#pragma unroll
        for (int dt = 0; dt < 4; ++dt) {
            const h16x4 lo = vtr(vb + ((dt ^ sw) << 5)), hi = vtr(vb + 2048 + ((dt ^ sw) << 5));
            o[dt] = __builtin_amdgcn_mfma_f32_16x16x32_f16(cat8(lo, hi), pf, o[dt], 0, 0, 0);
        }
    }
}
template <bool CAUSAL, bool SHARED>
__device__ __forceinline__ void attn_tile2(LAS const unsigned char* Ka, LAS const unsigned char* Va, LAS const unsigned char* Kb, LAS const unsigned char* Vb, int nsteps,
                                           h16x8 qa0, h16x8 qa1, float mba, int qrela, h16x8 qb0, h16x8 qb1, float mbb, int qrelb,
                                           f32x4 (&oa)[4], f32x4 (&ob)[4], float& lsa_out, float& lsb_out, int lane) {
    const int fr = lane & 15, G = lane >> 4, qq = fr >> 2, p = fr & 3;
    const int kof0 = fr * 128 + (((0 + G) ^ (fr & 7)) << 4), kof1 = fr * 128 + (((4 + G) ^ (fr & 7)) << 4);
    const int vrow = (4 * G + qq) * 128 + p * 8, sw = (2 * G + (qq >> 1)) & 3;
    const h16x8 ones = {(_Float16)1.0f, (_Float16)1.0f, (_Float16)1.0f, (_Float16)1.0f, (_Float16)1.0f, (_Float16)1.0f, (_Float16)1.0f, (_Float16)1.0f};
    const f32x4 nma = {-mba, -mba, -mba, -mba}, nmb = {-mbb, -mbb, -mbb, -mbb};
    f32x4 la = {0.f, 0.f, 0.f, 0.f}, lb = la;
    h16x8 ka[4], kb[4];
    ka[0] = *(LAS const h16x8*)(Ka + kof0); ka[1] = *(LAS const h16x8*)(Ka + kof1); ka[2] = *(LAS const h16x8*)(Ka + 2048 + kof0); ka[3] = *(LAS const h16x8*)(Ka + 2048 + kof1);
    if (!SHARED) { kb[0] = *(LAS const h16x8*)(Kb + kof0); kb[1] = *(LAS const h16x8*)(Kb + kof1); kb[2] = *(LAS const h16x8*)(Kb + 2048 + kof0); kb[3] = *(LAS const h16x8*)(Kb + 2048 + kof1); }
    for (int ks = 0; ks < nsteps; ++ks) {
        LAS const unsigned char* va = Va + ks * 4096 + vrow; LAS const unsigned char* vb = Vb + ks * 4096 + vrow;
        h16x4 fal[4], fah[4], fbl[4], fbh[4];
#pragma unroll
        for (int dt = 0; dt < 4; ++dt) { fal[dt] = vtr(va + ((dt ^ sw) << 5)); fah[dt] = vtr(va + 2048 + ((dt ^ sw) << 5));
            if (!SHARED) { fbl[dt] = vtr(vb + ((dt ^ sw) << 5)); fbh[dt] = vtr(vb + 2048 + ((dt ^ sw) << 5)); } }
        __builtin_amdgcn_sched_barrier(0);
        f32x4 sa0, sa1, sb0, sb1;
        sa0 = __builtin_amdgcn_mfma_f32_16x16x32_f16(ka[0], qa0, nma, 0, 0, 0); sb0 = __builtin_amdgcn_mfma_f32_16x16x32_f16(SHARED ? ka[0] : kb[0], qb0, nmb, 0, 0, 0);
        sa1 = __builtin_amdgcn_mfma_f32_16x16x32_f16(ka[2], qa0, nma, 0, 0, 0); sb1 = __builtin_amdgcn_mfma_f32_16x16x32_f16(SHARED ? ka[2] : kb[2], qb0, nmb, 0, 0, 0);
        sa0 = __builtin_amdgcn_mfma_f32_16x16x32_f16(ka[1], qa1, sa0, 0, 0, 0); sb0 = __builtin_amdgcn_mfma_f32_16x16x32_f16(SHARED ? ka[1] : kb[1], qb1, sb0, 0, 0, 0);
        sa1 = __builtin_amdgcn_mfma_f32_16x16x32_f16(ka[3], qa1, sa1, 0, 0, 0); sb1 = __builtin_amdgcn_mfma_f32_16x16x32_f16(SHARED ? ka[3] : kb[3], qb1, sb1, 0, 0, 0);
        __builtin_amdgcn_sched_barrier(0);
        if (ks + 1 < nsteps) { LAS const unsigned char* kn = Ka + (ks + 1) * 4096;
            ka[0] = *(LAS const h16x8*)(kn + kof0); ka[1] = *(LAS const h16x8*)(kn + kof1); ka[2] = *(LAS const h16x8*)(kn + 2048 + kof0); ka[3] = *(LAS const h16x8*)(kn + 2048 + kof1);
            if (!SHARED) { LAS const unsigned char* kn2 = Kb + (ks + 1) * 4096;
                kb[0] = *(LAS const h16x8*)(kn2 + kof0); kb[1] = *(LAS const h16x8*)(kn2 + kof1); kb[2] = *(LAS const h16x8*)(kn2 + 2048 + kof0); kb[3] = *(LAS const h16x8*)(kn2 + 2048 + kof1); } }
        __builtin_amdgcn_sched_barrier(0);
        f32x4 pa0, pa1, pb0, pb1;
#pragma unroll
        for (int e = 0; e < 4; ++e) { pa0[e] = __builtin_amdgcn_exp2f(sa0[e]); pa1[e] = __builtin_amdgcn_exp2f(sa1[e]);
                                      pb0[e] = __builtin_amdgcn_exp2f(sb0[e]); pb1[e] = __builtin_amdgcn_exp2f(sb1[e]); }
        if (CAUSAL) { const int kr = ks * 32 + 4 * G;
#pragma unroll
            for (int e = 0; e < 4; ++e) { if (kr + e > qrela) pa0[e] = 0.f; if (kr + 16 + e > qrela) pa1[e] = 0.f; if (kr + e > qrelb) pb0[e] = 0.f; if (kr + 16 + e > qrelb) pb1[e] = 0.f; } }
        u32x4 wa, wb; wa.x = pkh(pa0[0], pa0[1]); wa.y = pkh(pa0[2], pa0[3]); wa.z = pkh(pa1[0], pa1[1]); wa.w = pkh(pa1[2], pa1[3]);
        wb.x = pkh(pb0[0], pb0[1]); wb.y = pkh(pb0[2], pb0[3]); wb.z = pkh(pb1[0], pb1[1]); wb.w = pkh(pb1[2], pb1[3]);
        const h16x8 pfa = __builtin_bit_cast(h16x8, wa), pfb = __builtin_bit_cast(h16x8, wb);
        la = __builtin_amdgcn_mfma_f32_16x16x32_f16(ones, pfa, la, 0, 0, 0); lb = __builtin_amdgcn_mfma_f32_16x16x32_f16(ones, pfb, lb, 0, 0, 0);
#pragma unroll
        for (int dt = 0; dt < 4; ++dt) {
            const h16x8 fa = cat8(fal[dt], fah[dt]);
            const h16x8 fb = SHARED ? fa : cat8(fbl[dt], fbh[dt]);
            oa[dt] = __builtin_amdgcn_mfma_f32_16x16x32_f16(fa, pfa, oa[dt], 0, 0, 0);
            ob[dt] = __builtin_amdgcn_mfma_f32_16x16x32_f16(fb, pfb, ob[dt], 0, 0, 0);
        }
    }
    lsa_out = la[0]; lsb_out = lb[0];
}
__device__ __forceinline__ float wave_max(float v) {
#pragma unroll
    for (int o = 1; o < 64; o <<= 1) v = fmaxf(v, __shfl_xor(v, o));
    return v;
}
__device__ __forceinline__ void xattn_load_q(const f16_t* qp  , const float* gqm, int G, float maxgk, h16x8& q0, h16x8& q1, float& mb) {
    const h16x8 r0v = *(const h16x8*)qp, r1v = *(const h16x8*)(qp + 32);
    float q[16], ss = 0.f;
#pragma unroll
    for (int j = 0; j < 8; ++j) { q[j] = (float)r0v[j]; q[8 + j] = (float)r1v[j]; ss += q[j] * q[j] + q[8 + j] * q[8 + j]; }
    ss += __shfl_xor(ss, 16); ss += __shfl_xor(ss, 32);
    const float rn = 1.0f / sqrtf(ss * (1.0f / HD) + EPS);
    float n2 = 0.f;
#pragma unroll
    for (int j = 0; j < 8; ++j) { q[j] *= rn * gqm[8 * G + j]; q[8 + j] *= rn * gqm[32 + 8 * G + j]; n2 += q[j] * q[j] + q[8 + j] * q[8 + j]; }
    n2 += __shfl_xor(n2, 16); n2 += __shfl_xor(n2, 32);
    mb = (sqrtf(n2) * maxgk - BOUND_SHIFT) * LOG2E;
    const float c = 0.125f * LOG2E;
    u32x4 w0, w1;
    w0.x = pkh(q[0] * c, q[1] * c); w0.y = pkh(q[2] * c, q[3] * c); w0.z = pkh(q[4] * c, q[5] * c); w0.w = pkh(q[6] * c, q[7] * c);
    w1.x = pkh(q[8] * c, q[9] * c); w1.y = pkh(q[10] * c, q[11] * c); w1.z = pkh(q[12] * c, q[13] * c); w1.w = pkh(q[14] * c, q[15] * c);
    q0 = __builtin_bit_cast(h16x8, w0); q1 = __builtin_bit_cast(h16x8, w1);
}
template <bool Y8>
__device__ __forceinline__ void xattn_chunk(const Frame& F, const Args& a, int chunk, const f16_t* P, int ldp, int qcol0, const float* gqm, f16_t* Y) {
    const float* gkm = a.in[15];
    const f16_t* KM = (const f16_t*)(a.ws + WS_KM16); const f16_t* VM = (const f16_t*)(a.ws + WS_VM16);
    const int r0 = chunk * CHUNK, b = r0 / SEQ, lane = F.lane, fr = lane & 15, G = lane >> 4;
    const float maxgk = wave_max(fabsf(gkm[lane]));
    const int hsel = F.wave >> 2, rowa = r0 + 32 * (F.wave & 3) + fr, rowb = rowa + 16;
    for (int hp = 0; hp < 2; ++hp) {
#pragma unroll
        for (int k = 0; k < 2; ++k) dma_kv_imgs(F.lds + k * 65536, F.lds + k * 65536 + 32768, KM + (size_t)(b * 4 + 2 * hp + k) * NMEM * HD, VM + (size_t)(b * 4 + 2 * hp + k) * NMEM * HD, F.wave, lane, HD);
        const int head = 2 * hp + hsel;
        h16x8 qa0, qa1, qb0, qb1; float mba, mbb;
        xattn_load_q(P + (size_t)rowa * ldp + qcol0 + head * HD + 8 * G, gqm, G, maxgk, qa0, qa1, mba);
        xattn_load_q(P + (size_t)rowb * ldp + qcol0 + head * HD + 8 * G, gqm, G, maxgk, qb0, qb1, mbb);
        VM_WAIT();
        __syncthreads();
        f32x4 oa[4], ob[4]; float lsa = 0.f, lsb = 0.f;
#pragma unroll
        for (int dt = 0; dt < 4; ++dt) { oa[dt] = (f32x4){0.f, 0.f, 0.f, 0.f}; ob[dt] = oa[dt]; }
        LAS const unsigned char* img = F.lds + hsel * 65536;
        attn_tile2<false, true>(img, img + 32768, img, img + 32768, NMEM / 32, qa0, qa1, mba, 0, qb0, qb1, mbb, 0, oa, ob, lsa, lsb, lane);
        const float ila = 1.0f / lsa, ilb = 1.0f / lsb;
        if constexpr (Y8) { unsigned char* yp = (unsigned char*)Y + MIXW + head * HD; store_o8(yp + (size_t)rowa * DM, oa, ila, G); store_o8(yp + (size_t)rowb * DM, ob, ilb, G); }
        else { f16_t* yp = Y + MIXW + head * HD; store_o16(yp + (size_t)rowa * DM, oa, ila, G); store_o16(yp + (size_t)rowb * DM, ob, ilb, G); }
        __syncthreads();
    }
}

template <bool DO_SGU, bool DO_X>
__device__ __forceinline__ void mixer_a(const Frame& F, const Args& a) {
    const f16_t* P = (const f16_t*)(a.ws + WS_P16); f16_t* Y = (f16_t*)(a.ws + WS_Y16);
    const float* ssv = (const float*)(F.ctl + CW_SSV); const float* gsgu = a.in[6]; const float* wsp = a.in[7]; const float* bsp = a.in[8];
    LAS float* rv = (LAS float*)(F.lds + XCH_OFF);
    const int lane = F.lane, fr = lane & 15, G = lane >> 4, qq = fr >> 2, p = fr & 3, w = F.wave;
    for (int chunk = F.vcu; chunk < M / CHUNK; chunk += F.G) {
        const int r0 = chunk * CHUNK;
        if (F.tid < CHUNK) rv[F.tid] = 1.0f / sqrtf(ssv[r0 + F.tid] * (1.0f / MIXW) + EPS);
        __syncthreads();
        h16x8 zvr[4];
        if (DO_SGU) {
#pragma unroll
            for (int k4 = 0; k4 < 4; ++k4) { const int ci = F.tid + 512 * k4, s2 = ci >> 4, c = ci & 15; zvr[k4] = __builtin_nontemporal_load((const h16x8*)(P + (size_t)(r0 + s2) * NA + MIXW + 8 * c)); } }
        for (int g = 0; g < (DO_SGU ? NGRP : 0); ++g) {
            LAS unsigned char* Wimg = F.lds + (g & 1) * 65536; LAS unsigned char* Vimg = Wimg + 32768;
            { const int c = F.tid & 15; const f32x4 g0 = *(const f32x4*)(gsgu + g * 128 + 8 * c), g1 = *(const f32x4*)(gsgu + g * 128 + 8 * c + 4);
#pragma unroll
              for (int k4 = 0; k4 < 4; ++k4) { const int s2 = (F.tid + 512 * k4) >> 4; const h16x8 zv = zvr[k4]; const float rs = rv[s2];
                u32x4 o; o.x = pkh((float)zv[0] * rs * g0[0], (float)zv[1] * rs * g0[1]); o.y = pkh((float)zv[2] * rs * g0[2], (float)zv[3] * rs * g0[3]);
                o.z = pkh((float)zv[4] * rs * g1[0], (float)zv[5] * rs * g1[1]); o.w = pkh((float)zv[6] * rs * g1[2], (float)zv[7] * rs * g1[3]);
                *(LAS u32x4*)(Vimg + s2 * 256 + (((c >> 1) ^ (s2 & 7)) << 5) + ((c & 1) << 4)) = o; } }
            { const unsigned wd = (unsigned)__builtin_amdgcn_readfirstlane((int)(unsigned)(uintptr_t)Wimg);
#pragma unroll
              for (int i = 0; i < 4; ++i) { const int pc = w + 8 * i; glds16_asm(a.ws + WS_W16S + (size_t)g * 32768 + pc * 1024 + lane * 16, (unsigned)__builtin_amdgcn_readfirstlane((int)(wd + pc * 1024))); } }
            const int t = 16 * w + fr, row = r0 + t;
            h16x8 ur[4];
#pragma unroll
            for (int pr = 0; pr < 4; ++pr) ur[pr] = __builtin_nontemporal_load((const h16x8*)(P + (size_t)row * NA + g * 128 + pair16_dim(G, 2 * pr)));
            if (g + 1 < NGRP) {
#pragma unroll
                for (int k4 = 0; k4 < 4; ++k4) { const int ci = F.tid + 512 * k4, s2 = ci >> 4, c = ci & 15; zvr[k4] = __builtin_nontemporal_load((const h16x8*)(P + (size_t)(r0 + s2) * NA + MIXW + (g + 1) * 128 + 8 * c)); }
                asm volatile("s_waitcnt vmcnt(8)" ::: "memory");
            } else asm volatile("s_waitcnt vmcnt(4)" ::: "memory");
            __syncthreads();
            f32x4 acc[8];
#pragma unroll
            for (int dt = 0; dt < 8; ++dt) acc[dt] = (f32x4){0.f, 0.f, 0.f, 0.f};
            const int nsteps = (w >> 1) + 1;
            for (int ks = 0; ks < nsteps; ++ks) {
                const h16x8 bf = *(LAS const h16x8*)(Wimg + (16 * w + fr) * 256 + (((4 * ks + G) ^ fr) << 4));
                LAS const unsigned char* v0 = Vimg + (32 * ks + 8 * G + qq) * 256 + p * 8;
#pragma unroll
                for (int dt = 0; dt < 8; ++dt) {
                    const h16x4 lo = vtr(v0 + ((dt ^ qq) << 5)), hi = vtr(v0 + 4 * 256 + ((dt ^ (4 + qq)) << 5));
                    acc[dt] = __builtin_amdgcn_mfma_f32_16x16x32_f16(cat8(lo, hi), bf, acc[dt], 0, 0, 0);
                }
            }
            const float bias = bsp[g * CHUNK + t];
#pragma unroll
            for (int pr = 0; pr < 4; ++pr) { const int dt0 = 2 * pr, col = g * 128 + pair16_dim(G, dt0);
                u32x2 xa, xb; xa.x = pkh(acc[dt0][0] + bias, acc[dt0][1] + bias); xa.y = pkh(acc[dt0][2] + bias, acc[dt0][3] + bias);
                xb.x = pkh(acc[dt0 + 1][0] + bias, acc[dt0 + 1][1] + bias); xb.y = pkh(acc[dt0 + 1][2] + bias, acc[dt0 + 1][3] + bias);
                const h16x8 m8 = __builtin_bit_cast(h16x8, pair16(xa, xb));
                *(h16x8*)(Y + (size_t)row * DM + col) = ur[pr] * m8; }
        }
        __syncthreads();
        if (DO_X) xattn_chunk<false>(F, a, chunk, P, NA, 2 * MIXW, a.in[16], Y);
    }
}

__device__ __forceinline__ void moba_load_q(const f16_t* qrow, int G, float maxgk, h16x8& q0, h16x8& q1, float& mb) {
    const h16x8 r0v = *(const h16x8*)(qrow + 8 * G), r1v = *(const h16x8*)(qrow + 32 + 8 * G);
    float q[16], n2 = 0.f;
#pragma unroll
    for (int j = 0; j < 8; ++j) { q[j] = (float)r0v[j]; q[8 + j] = (float)r1v[j]; n2 += q[j] * q[j] + q[8 + j] * q[8 + j]; }
    n2 += __shfl_xor(n2, 16); n2 += __shfl_xor(n2, 32);
    mb = (sqrtf(n2) * maxgk - BOUND_SHIFT) * LOG2E;
    const float c = 0.125f * LOG2E;
    u32x4 w0, w1;
    w0.x = pkh(q[0] * c, q[1] * c); w0.y = pkh(q[2] * c, q[3] * c); w0.z = pkh(q[4] * c, q[5] * c); w0.w = pkh(q[6] * c, q[7] * c);
    w1.x = pkh(q[8] * c, q[9] * c); w1.y = pkh(q[10] * c, q[11] * c); w1.z = pkh(q[12] * c, q[13] * c); w1.w = pkh(q[14] * c, q[15] * c);
    q0 = __builtin_bit_cast(h16x8, w0); q1 = __builtin_bit_cast(h16x8, w1);
}
__device__ __forceinline__ void moba_finish_q(h16x8 r0v, h16x8 r1v, float maxgk, h16x8& q0, h16x8& q1, float& mb) {
    float q[16], n2 = 0.f;
#pragma unroll
    for (int j = 0; j < 8; ++j) { q[j] = (float)r0v[j]; q[8 + j] = (float)r1v[j]; n2 += q[j] * q[j] + q[8 + j] * q[8 + j]; }
    n2 += __shfl_xor(n2, 16); n2 += __shfl_xor(n2, 32);
    mb = (sqrtf(n2) * maxgk - BOUND_SHIFT) * LOG2E;
    const float c = 0.125f * LOG2E;
    u32x4 w0, w1;
    w0.x = pkh(q[0] * c, q[1] * c); w0.y = pkh(q[2] * c, q[3] * c); w0.z = pkh(q[4] * c, q[5] * c); w0.w = pkh(q[6] * c, q[7] * c);
    w1.x = pkh(q[8] * c, q[9] * c); w1.y = pkh(q[10] * c, q[11] * c); w1.z = pkh(q[12] * c, q[13] * c); w1.w = pkh(q[14] * c, q[15] * c);
    q0 = __builtin_bit_cast(h16x8, w0); q1 = __builtin_bit_cast(h16x8, w1);
}
constexpr int LIST_CAP = 768, OFFS_LD = 68;

__device__ __forceinline__ unsigned sel_key(float g, int j) {
    const unsigned b = __builtin_bit_cast(unsigned, g);
    const unsigned o = (b & 0x80000000u) ? ~b : (b | 0x80000000u);
    return (o & ~63u) | (unsigned)(63 - j);
}
#define SEL_INSERT(k) do { const unsigned a_ = min(t0, (k)); t0 = max(t0, (k)); const unsigned b_ = min(t1, a_); t1 = max(t1, a_); t2 = max(t2, b_); } while (0)
__device__ __forceinline__ void moba_select(const Frame& F, const Args& a) {
    const f16_t* P = (const f16_t*)(a.ws + WS_P16);
    const float* kmean = (const float*)(F.ctl + CW_KMEAN);
    unsigned short* LIST = (unsigned short*)(a.ws + WS_LIST); unsigned short* OFFS = (unsigned short*)(a.ws + WS_OFFS);
    LAS unsigned char* KMhi = F.lds; LAS unsigned char* KMlo = F.lds + 8192;
    LAS int* cnt = (LAS int*)(F.lds + 16384);
    LAS int* off = cnt + 64;
    LAS int* cur = off + 72;
    LAS unsigned short* sorted = (LAS unsigned short*)(F.lds + 17408);
    const int lane = F.lane, fr = lane & 15, G = lane >> 4, w = F.wave, tid = F.tid;
    for (int unit = F.vcu; unit < BATCH * NBLK * MOBA_H; unit += F.G) {
        const int h = unit % MOBA_H, qb = (unit / MOBA_H) % NBLK, b = unit / (MOBA_H * NBLK);
        const size_t ub = (size_t)(b * MOBA_H + h) * NBLK + qb;
        __syncthreads();
        if (tid < 64) { cnt[tid] = 0; cur[tid] = 0; }
        { const int j = tid >> 3, c = tid & 7; const float* src = kmean + ((size_t)(b * MOBA_H + h) * NBLK + j) * HD + 8 * c;
          const f32x4 x0 = *(const f32x4*)src, x1 = *(const f32x4*)(src + 4);
          const float v[8] = {x0[0], x0[1], x0[2], x0[3], x1[0], x1[1], x1[2], x1[3]}; float hi[8], lo[8];
#pragma unroll
          for (int e = 0; e < 8; ++e) { hi[e] = (float)(_Float16)v[e]; lo[e] = v[e] - hi[e]; }
          u32x4 wh, wl; wh.x = pkh(hi[0], hi[1]); wh.y = pkh(hi[2], hi[3]); wh.z = pkh(hi[4], hi[5]); wh.w = pkh(hi[6], hi[7]);
          wl.x = pkh(lo[0], lo[1]); wl.y = pkh(lo[2], lo[3]); wl.z = pkh(lo[4], lo[5]); wl.w = pkh(lo[6], lo[7]);
          *(LAS u32x4*)(KMhi + j * 128 + ((c ^ (j & 7)) << 4)) = wh; *(LAS u32x4*)(KMlo + j * 128 + ((c ^ (j & 7)) << 4)) = wl; }
        __syncthreads();
        const int nsel = qb < 3 ? qb : 3, njt = qb > 0 ? ((qb - 1) >> 4) + 1 : 0;
        int isel[2] = {0, 0};
#pragma unroll
        for (int rep = 0; rep < 2; ++rep) {
            const int qi = 16 * (w + 8 * rep) + fr;
            const f16_t* qp = P + (size_t)(b * SEQ + qb * MOBA_BLK + qi) * NB + h * HD + 8 * G;
            const h16x8 q0 = *(const h16x8*)qp, q1 = *(const h16x8*)(qp + 32);
            unsigned t0 = 0u, t1 = 0u, t2 = 0u;
            const int kof0 = fr * 128 + (((0 + G) ^ (fr & 7)) << 4), kof1 = fr * 128 + (((4 + G) ^ (fr & 7)) << 4);
            for (int jt = 0; jt < njt; ++jt) {
                f32x4 acc = {0.f, 0.f, 0.f, 0.f};
                acc = __builtin_amdgcn_mfma_f32_16x16x32_f16(*(LAS const h16x8*)(KMhi + jt * 2048 + kof0), q0, acc, 0, 0, 0);
                acc = __builtin_amdgcn_mfma_f32_16x16x32_f16(*(LAS const h16x8*)(KMhi + jt * 2048 + kof1), q1, acc, 0, 0, 0);
                acc = __builtin_amdgcn_mfma_f32_16x16x32_f16(*(LAS const h16x8*)(KMlo + jt * 2048 + kof0), q0, acc, 0, 0, 0);
                acc = __builtin_amdgcn_mfma_f32_16x16x32_f16(*(LAS const h16x8*)(KMlo + jt * 2048 + kof1), q1, acc, 0, 0, 0);
#pragma unroll
                for (int e = 0; e < 4; ++e) { const int j = 16 * jt + 4 * G + e; const unsigned k = (j < qb) ? sel_key(acc[e], j) : 0u; SEL_INSERT(k); }
            }
#pragma unroll
            for (int x = 16; x <= 32; x <<= 1) {
                const unsigned p0 = (unsigned)__shfl_xor((int)t0, x), p1 = (unsigned)__shfl_xor((int)t1, x), p2 = (unsigned)__shfl_xor((int)t2, x);
                SEL_INSERT(p0); SEL_INSERT(p1); SEL_INSERT(p2);
            }
            const unsigned tk = (G == 0) ? t0 : (G == 1) ? t1 : t2;
            isel[rep] = 63 - (int)(tk & 63u);
            if (G < nsel) __hip_atomic_fetch_add(cnt + isel[rep], 1, __ATOMIC_RELAXED, __HIP_MEMORY_SCOPE_WORKGROUP);
        }
        __syncthreads();
        if (w == 0) { const int c = cnt[lane]; int s = c;
#pragma unroll
            for (int o = 1; o < 64; o <<= 1) { const int t = __shfl_up(s, o); if (lane >= o) s += t; }
            off[lane] = s - c; if (lane == 63) off[64] = s; }
        __syncthreads();
#pragma unroll
        for (int rep = 0; rep < 2; ++rep) if (G < nsel) {
            const int qi = 16 * (w + 8 * rep) + fr;
            const int pos = __hip_atomic_fetch_add(cur + isel[rep], 1, __ATOMIC_RELAXED, __HIP_MEMORY_SCOPE_WORKGROUP);
            sorted[off[isel[rep]] + pos] = (unsigned short)((qi << 2) | G); }
        __syncthreads();
        const int total = off[64];
        for (int k = tid; k < total; k += 512) LIST[ub * LIST_CAP + k] = sorted[k];
        if (tid < 65) OFFS[ub * OFFS_LD + tid] = (unsigned short)off[tid];
    }
}
#undef SEL_INSERT

constexpr int SP_PART = 512;
struct SpItem { int n, lq, j; unsigned short raw; };
__device__ __forceinline__ void sp_prefetch(int it, int bh, LAS const int* IP, LAS const int* NJ, LAS const unsigned short* cum, LAS const unsigned short* offs, const unsigned short* LIST,
                                            const f16_t* P, LAS unsigned char* img, int wave, int lane, int tid, SpItem& o) {
    int l2 = 0, h2 = 64; while (h2 - l2 > 1) { const int mid = (l2 + h2) >> 1; if (IP[mid] <= it) l2 = mid; else h2 = mid; }
    const int j = l2, part = it - IP[l2], b = bh / MOBA_H, h = bh % MOBA_H;
    int n = NJ[j] - part * SP_PART; if (n > SP_PART) n = SP_PART; o.n = n; o.j = j;
    const f16_t* kb = P + (size_t)(b * SEQ + j * MOBA_BLK) * NB + MIXW + h * HD;
    dma_kv_imgs(img, img + 32768, kb, kb + MIXW, wave, lane);
    const int ei = (lane < 32) ? 32 * wave + lane : 256 + 32 * wave + (lane - 32);
    if (ei < n) { const int e = part * SP_PART + ei; const LAS unsigned short* cj = cum + j; int lq = 0, hq = 64;
        while (hq - lq > 1) { const int mid = (lq + hq) >> 1; if ((int)cj[mid * NBLK] <= e) lq = mid; else hq = mid; }
        o.lq = lq;
        o.raw = LIST[((size_t)bh * NBLK + lq) * LIST_CAP + offs[lq * OFFS_LD + j] + (e - (int)cj[lq * NBLK])]; }
}
template <bool ENGINE, int ESTEPS>
__device__ __forceinline__ void moba_sparse(const Frame& F, const Args& a, int rep) {
    const f16_t* P = (const f16_t*)(a.ws + WS_P16);
    const unsigned short* LIST = (const unsigned short*)(a.ws + WS_LIST); const unsigned short* OFFS = (const unsigned short*)(a.ws + WS_OFFS);
    f16_t* PO = (f16_t*)(a.ws + WS_PO); float* PL = (float*)(a.ws + WS_PL);
    const int ncl = F.G / 8; if (ncl == 0) return;
    const int xg = F.vcu / ncl; if (xg >= 8) return;
    LAS unsigned short* offs = (LAS unsigned short*)(F.lds + 131072);
    LAS unsigned short* cum = (LAS unsigned short*)(F.lds + 139776);
    LAS int* NJ = (LAS int*)(F.lds + 147968);
    LAS int* IP = NJ + 64;
    LAS unsigned* plist = (LAS unsigned*)(F.lds + 148992);
    LAS int* itq = (LAS int*)(F.lds + 151040);
    const int lane = F.lane, fr = lane & 15, G = lane >> 4, w = F.wave, tid = F.tid;
    const float maxgk = wave_max(fabsf(a.in[12][lane]));
    for (int bl = 0; bl < 3; ++bl) {
        const int bh = xg + 8 * bl, b = bh / MOBA_H, h = bh % MOBA_H;
        unsigned* qctr = (unsigned*)(F.ctl + CW_QUEUE + 64 * (xg * 3 + bl) + 2048 * rep);
        __syncthreads();
        for (int i = tid; i < NBLK * OFFS_LD / 2; i += 512) ((LAS unsigned*)offs)[i] = ((const unsigned*)(OFFS + (size_t)bh * NBLK * OFFS_LD))[i];
        if (tid == 0) { itq[0] = (int)__hip_atomic_fetch_add(qctr, 1u, RLX_AGENT); itq[1] = (int)__hip_atomic_fetch_add(qctr, 1u, RLX_AGENT); }
        __syncthreads();
        if (tid < 64) { const int j = tid; int acc = 0;
            for (int qb = 0; qb < NBLK; ++qb) { cum[qb * NBLK + j] = (unsigned short)acc;
                if (qb > j && j < NBLK - 1) acc += (int)offs[qb * OFFS_LD + j + 1] - (int)offs[qb * OFFS_LD + j]; }
            NJ[j] = acc;
            const int c = (acc + SP_PART - 1) / SP_PART; int s = c;
#pragma unroll
            for (int o = 1; o < 64; o <<= 1) { const int t = __shfl_up(s, o); if (lane >= o) s += t; }
            IP[j] = s - c; if (j == 63) IP[64] = s; }
        __syncthreads();
        const int TI = IP[64];
        int it_cur = itq[0], it_nxt = itq[1], cb = 0;
        SpItem pf; pf.n = 0; pf.lq = 0; pf.j = 0; pf.raw = 0;
        if (it_cur < TI) sp_prefetch(it_cur, bh, IP, NJ, cum, offs, LIST, P, F.lds, w, lane, tid, pf);
        const int ei = (lane < 32) ? 32 * w + lane : 256 + 32 * w + (lane - 32);
        bool qready = false;
        int n = 0; unsigned ment = 0u, ea = 0u, eb = 0u; h16x8 ra0, ra1, rb0, rb1;
        for (int iter = 0;; ++iter) {
            const int coming = (iter == 0) ? it_cur : it_nxt; const bool have = coming < TI;
            if (!qready) {
                VM_WAIT();
                n = have ? pf.n : 0;
                ment = 0u; if (ei < n) ment = ((unsigned)(pf.lq * MOBA_BLK + (int)(pf.raw >> 2)) << 2) | (unsigned)(pf.raw & 3);
                const int nq = n - 32 * w;
                if (nq > 0) { ea = (unsigned)__shfl((int)ment, fr < nq ? fr : nq - 1); eb = (unsigned)__shfl((int)ment, 16 + fr < nq ? 16 + fr : nq - 1);
                    const f16_t* pa = P + (size_t)(b * SEQ + (int)(ea >> 2)) * NB + h * HD + 8 * G; const f16_t* pb = P + (size_t)(b * SEQ + (int)(eb >> 2)) * NB + h * HD + 8 * G;
                    ra0 = *(const h16x8*)pa; ra1 = *(const h16x8*)(pa + 32); rb0 = *(const h16x8*)pb; rb1 = *(const h16x8*)(pb + 32); }
            }
            const int nw0 = n - 32 * w, nw1 = n - 256 - 32 * w;
            __syncthreads();
            if (iter > 0) { it_cur = it_nxt; it_nxt = itq[0]; }
            if (it_cur >= TI) break;
            LAS const unsigned char* Kimg = F.lds + cb * 65536; LAS const unsigned char* Vimg = Kimg + 32768;
            unsigned nn = 0u; if (tid == 0) nn = __hip_atomic_fetch_add(qctr, 1u, RLX_AGENT);
            const int npairs = nw0 <= 0 ? 0 : (nw1 > 0 ? 2 : 1);
            const bool more = it_nxt < TI;
            if (more) sp_prefetch(it_nxt, bh, IP, NJ, cum, offs, LIST, P, F.lds + (cb ^ 1) * 65536, w, lane, tid, pf);
            qready = false;
            for (int k = 0; k < npairs; ++k) {
                const int nwk = k ? nw1 : nw0;
                const bool va = fr < nwk, vb = 16 + fr < nwk; const unsigned cea = ea, ceb = eb;
                const int ta = (int)(cea >> 2), tb = (int)(ceb >> 2);
                h16x8 qa0, qa1, qb0, qb1; float mba, mbb;
                moba_finish_q(ra0, ra1, maxgk, qa0, qa1, mba); moba_finish_q(rb0, rb1, maxgk, qb0, qb1, mbb);
                if (k + 1 < npairs) {
                    ea = (unsigned)__shfl((int)ment, 32 + (fr < nw1 ? fr : nw1 - 1)); eb = (unsigned)__shfl((int)ment, 32 + (16 + fr < nw1 ? 16 + fr : nw1 - 1));
                    const f16_t* pa = P + (size_t)(b * SEQ + (int)(ea >> 2)) * NB + h * HD + 8 * G; const f16_t* pb = P + (size_t)(b * SEQ + (int)(eb >> 2)) * NB + h * HD + 8 * G;
                    ra0 = *(const h16x8*)pa; ra1 = *(const h16x8*)(pa + 32); rb0 = *(const h16x8*)pb; rb1 = *(const h16x8*)(pb + 32); }
                else if (k == 1 && more) {
                    n = pf.n;
                    ment = 0u; if (ei < n) ment = ((unsigned)(pf.lq * MOBA_BLK + (int)(pf.raw >> 2)) << 2) | (unsigned)(pf.raw & 3);
                    const int nq = n - 32 * w;
                    if (nq > 0) { ea = (unsigned)__shfl((int)ment, fr < nq ? fr : nq - 1); eb = (unsigned)__shfl((int)ment, 16 + fr < nq ? 16 + fr : nq - 1);
                        const f16_t* pa = P + (size_t)(b * SEQ + (int)(ea >> 2)) * NB + h * HD + 8 * G; const f16_t* pb = P + (size_t)(b * SEQ + (int)(eb >> 2)) * NB + h * HD + 8 * G;
                        ra0 = *(const h16x8*)pa; ra1 = *(const h16x8*)(pa + 32); rb0 = *(const h16x8*)pb; rb1 = *(const h16x8*)(pb + 32); }
                    qready = true; }
                f32x4 oa[4], ob[4]; float lsa = 0.f, lsb = 0.f;
#pragma unroll
                for (int dt = 0; dt < 4; ++dt) { oa[dt] = (f32x4){0.f, 0.f, 0.f, 0.f}; ob[dt] = oa[dt]; }
                if (ENGINE || ESTEPS > 0) attn_tile2<false, true>(Kimg, Vimg, Kimg, Vimg, ENGINE ? MOBA_BLK / 32 : ESTEPS, qa0, qa1, mba, 0, qb0, qb1, mbb, 0, oa, ob, lsa, lsb, lane); else { lsa = mba; lsb = mbb; oa[0][0] = (float)qa0[0] + (float)qa1[1]; ob[0][0] = (float)qb0[0] + (float)qb1[1]; }
                const float ila = 1.0f / lsa, ilb = 1.0f / lsb;
                if (!ENGINE) { asm volatile("" :: "v"(lsa), "v"(lsb), "v"(oa[0][0]), "v"(ob[0][0])); }
                { const size_t pia = ((size_t)bh * SEQ + ta) * 3 + (cea & 3u), pib = ((size_t)bh * SEQ + tb) * 3 + (ceb & 3u);
                  u32x4 sa[2], sb[2];
#pragma unroll
                  for (int pr = 0; pr < 2; ++pr) { const int dt0 = 2 * pr; u32x2 x, y;
                      x.x = pkh(oa[dt0][0] * ila, oa[dt0][1] * ila); x.y = pkh(oa[dt0][2] * ila, oa[dt0][3] * ila); y.x = pkh(oa[dt0 + 1][0] * ila, oa[dt0 + 1][1] * ila); y.y = pkh(oa[dt0 + 1][2] * ila, oa[dt0 + 1][3] * ila); sa[pr] = pair16(x, y);
                      x.x = pkh(ob[dt0][0] * ilb, ob[dt0][1] * ilb); x.y = pkh(ob[dt0][2] * ilb, ob[dt0][3] * ilb); y.x = pkh(ob[dt0 + 1][0] * ilb, ob[dt0 + 1][1] * ilb); y.y = pkh(ob[dt0 + 1][2] * ilb, ob[dt0 + 1][3] * ilb); sb[pr] = pair16(x, y); }
                  if (va && ENGINE) { *(u32x4*)(PO + pia * HD + pair16_dim(G, 0)) = sa[0]; *(u32x4*)(PO + pia * HD + pair16_dim(G, 2)) = sa[1]; if (G == 0) PL[pia] = lsa; }
                  if (vb && ENGINE) { *(u32x4*)(PO + pib * HD + pair16_dim(G, 0)) = sb[0]; *(u32x4*)(PO + pib * HD + pair16_dim(G, 2)) = sb[1]; if (G == 0) PL[pib] = lsb; } }
            }
            if (tid == 0) itq[0] = (int)nn;
            cb ^= 1;
        }
    }
}

template <bool PR_ENG, bool PR_PART, bool PR_ST>
__device__ __forceinline__ void moba_own(const Frame& F, const Args& a) {
    const f16_t* P = (const f16_t*)(a.ws + WS_P16); f16_t* Y = (f16_t*)(a.ws + WS_Y16);
    const f16_t* PO = (const f16_t*)(a.ws + WS_PO); const float* PL = (const float*)(a.ws + WS_PL);
    const int lane = F.lane, fr = lane & 15, G = lane >> 4, w = F.wave;
    const float maxgk = wave_max(fabsf(a.in[12][lane]));
    for (int up = F.vcu; up < BATCH * MOBA_H * NBLK / 2; up += F.G) {
        const int bh = up / (NBLK / 2), b = bh / MOBA_H, h = bh % MOBA_H, qb0 = 2 * (up % (NBLK / 2));
        __syncthreads();
#pragma unroll
        for (int k = 0; k < 2; ++k) { const f16_t* kb = P + (size_t)(b * SEQ + (qb0 + k) * MOBA_BLK) * NB + MIXW + h * HD;
            dma_kv_imgs(F.lds + k * 65536, F.lds + k * 65536 + 32768, kb, kb + MIXW, w, lane); }
        const int dt0 = w, dt1 = 7 - w;
        const int tq[2][2] = {{qb0 * MOBA_BLK + 32 * dt0 + fr, qb0 * MOBA_BLK + 32 * dt0 + 16 + fr}, {(qb0 + 1) * MOBA_BLK + 32 * dt1 + fr, (qb0 + 1) * MOBA_BLK + 32 * dt1 + 16 + fr}};
        VM_WAIT();
        __syncthreads();
#pragma unroll
        for (int k = 0; k < 2; ++k) {
            const int qb = qb0 + k, nsel = qb < 3 ? qb : 3, dti = k ? dt1 : dt0;
            const int ta = tq[k][0], tb = tq[k][1];
            h16x8 q0[2][2], q1[2][2]; float mb[2][2];
#pragma unroll
            for (int t = 0; t < 2; ++t) moba_load_q(P + (size_t)(b * SEQ + tq[k][t]) * NB + h * HD, G, maxgk, q0[k][t], q1[k][t], mb[k][t]);
            f32x4 oa[4], ob[4]; float lsa = 0.f, lsb = 0.f;
#pragma unroll
            for (int dt = 0; dt < 4; ++dt) { oa[dt] = (f32x4){0.f, 0.f, 0.f, 0.f}; ob[dt] = oa[dt]; }
            LAS const unsigned char* Ki = F.lds + k * 65536;
            if (PR_ENG) attn_tile2<true, true>(Ki, Ki + 32768, Ki, Ki + 32768, dti + 1, q0[k][0], q1[k][0], mb[k][0], 32 * dti + fr, q0[k][1], q1[k][1], mb[k][1], 32 * dti + 16 + fr, oa, ob, lsa, lsb, lane); else { lsa = mb[k][0] + (float)q0[k][0][0] + (float)q1[k][0][1]; lsb = mb[k][1] + (float)q0[k][1][0] + (float)q1[k][1][1]; }
            float pl[2][3]; u32x4 pw[2][3][2];
#pragma unroll
            for (int slot = 0; slot < 3; ++slot) if (PR_PART && slot < nsel) {
                const size_t pia = ((size_t)bh * SEQ + ta) * 3 + slot, pib = ((size_t)bh * SEQ + tb) * 3 + slot;
                pl[0][slot] = __builtin_nontemporal_load(PL + pia); pl[1][slot] = __builtin_nontemporal_load(PL + pib);
#pragma unroll
                for (int pr = 0; pr < 2; ++pr) { pw[0][slot][pr] = __builtin_nontemporal_load((const u32x4*)(PO + pia * HD + pair16_dim(G, 2 * pr))); pw[1][slot][pr] = __builtin_nontemporal_load((const u32x4*)(PO + pib * HD + pair16_dim(G, 2 * pr))); } }
#pragma unroll
            for (int slot = 0; slot < 3; ++slot) if (PR_PART && slot < nsel) {
#pragma unroll
                for (int pr = 0; pr < 2; ++pr) { u32x2 xa, ya, xb, yb; unpair16(pw[0][slot][pr], xa, ya); unpair16(pw[1][slot][pr], xb, yb);
                    const h16x4 va0 = __builtin_bit_cast(h16x4, xa), va1 = __builtin_bit_cast(h16x4, ya), vb0 = __builtin_bit_cast(h16x4, xb), vb1 = __builtin_bit_cast(h16x4, yb);
#pragma unroll
                    for (int e = 0; e < 4; ++e) { oa[2 * pr][e] += pl[0][slot] * (float)va0[e]; oa[2 * pr + 1][e] += pl[0][slot] * (float)va1[e]; ob[2 * pr][e] += pl[1][slot] * (float)vb0[e]; ob[2 * pr + 1][e] += pl[1][slot] * (float)vb1[e]; } }
                lsa += pl[0][slot]; lsb += pl[1][slot]; }
            const float ila = 1.0f / lsa, ilb = 1.0f / lsb;
            if (PR_ST) { store_o8((unsigned char*)Y + (size_t)(b * SEQ + ta) * DM + h * HD, oa, ila, G); store_o8((unsigned char*)Y + (size_t)(b * SEQ + tb) * DM + h * HD, ob, ilb, G); }
            else asm volatile("" :: "v"(oa[0][0] * ila), "v"(ob[0][0] * ilb));
        }
    }
}
__device__ __forceinline__ void xattn_b(const Frame& F, const Args& a) {
    const f16_t* P = (const f16_t*)(a.ws + WS_P16); f16_t* Y = (f16_t*)(a.ws + WS_Y16);
    __syncthreads();
    for (int chunk = F.vcu; chunk < M / CHUNK; chunk += F.G) xattn_chunk<true>(F, a, chunk, P, NB, 3 * MIXW, a.in[16] + HD, Y);
}

__device__ __forceinline__ void ffn_fixup(const Frame& F, const float* bnd_g, const float* cw, const float* cb, f16_t* U) {
    constexpr int HALF = pg8::HALF, NNU = FF2 / 256, TOTAL = (M / 256) * NNU * HALF, NIT = 3;
    const int stride = F.G * (NWAVES * 64);
    for (int base = F.vcu * (NWAVES * 64) + F.tid; base < TOTAL; base += NIT * stride) {
    float x[NIT][2][4], wv[NIT][2][4];
#pragma unroll
    for (int k = 0; k < NIT; ++k) {
        const int idx = base + k * stride, id2 = idx < TOTAL ? idx : 0;
        const int j = id2 & (HALF - 1), unit = id2 >> 7, pm = unit / NNU, pn = unit % NNU;
        const float* own = bnd_g + (size_t)unit * 1024; const bool first = (pm % (SEQ / 256)) == 0; const float* prv = first ? own : own - (size_t)NNU * 1024;
#pragma unroll
        for (int part = 0; part < 2; ++part) {
            const int c = part * HALF + j, gc = part * FF + pn * HALF + j;
            const float a2 = prv[2 * 256 + c], a1 = prv[3 * 256 + c];
            x[k][part][0] = first ? 0.f : a2; x[k][part][1] = first ? 0.f : a1; x[k][part][2] = own[c]; x[k][part][3] = own[256 + c];
            wv[k][part][0] = cw[gc]; wv[k][part][1] = cw[FF2 + gc]; wv[k][part][2] = cw[2 * FF2 + gc]; wv[k][part][3] = cb[gc];
        }
    }
#pragma unroll
    for (int k = 0; k < NIT; ++k) {
        const int idx = base + k * stride; if (idx >= TOTAL) break;
        const int j = idx & (HALF - 1), unit = idx >> 7, pm = unit / NNU, pn = unit % NNU;
        float h0[2], h1[2];
#pragma unroll
        for (int part = 0; part < 2; ++part) {
            h0[part] = fmaf(wv[k][part][0], x[k][part][0], fmaf(wv[k][part][1], x[k][part][1], fmaf(wv[k][part][2], x[k][part][2], wv[k][part][3])));
            h1[part] = fmaf(wv[k][part][0], x[k][part][1], fmaf(wv[k][part][1], x[k][part][2], fmaf(wv[k][part][2], x[k][part][3], wv[k][part][3])));
        }
        f16_t* up = U + (size_t)(pm * 256) * FF + pn * HALF + j;
        up[0] = f2h(gelu_tanh(h0[0]) * h0[1]); up[FF] = f2h(gelu_tanh(h1[0]) * h1[1]);
    }
    }
}

__global__ void __launch_bounds__(NWAVES * 64, 2) fwd_kernel(Args args) {
    extern __shared__ __attribute__((aligned(16))) unsigned char lds_raw[];
    Frame F;
    F.lds = (LAS unsigned char*)lds_raw;
    F.MISC = (volatile LAS unsigned*)(F.lds + MISC_OFF);
    F.tid = threadIdx.x; F.lane = F.tid & 63; F.wave = __builtin_amdgcn_readfirstlane(F.tid >> 6);
    F.G = gridDim.x; { const int bx = blockIdx.x; F.vcu = (F.G % 8 == 0) ? (bx % 8) * (F.G / 8) + bx / 8 : bx; }
    unsigned char* ws = args.ws;
    F.ctl = (gu32*)(ws + WS_CTL);
    for (int u = F.tid; u < 64; u += NWAVES * 64) ((LAS unsigned*)(F.lds + MISC_OFF))[u] = 0u;
    __syncthreads();
    const int lo = args.ph_lo, hi = args.ph_hi;
    XcdBarrier bar; bar.bar = (unsigned*)(F.ctl + CW_BAR); bar.x = 0; bar.st = nullptr;
    if (hi - lo > 1) bar = xcd_barrier_post((unsigned*)(F.ctl + CW_BAR), F.MISC + 8);
#define IN(k) (lo <= (k) && (k) < hi)
#ifndef PROBE_BARX
#define PROBE_BARX 0
#endif
#define SEAM(k) do { if (IN(k) && IN((k) + 1)) { xcd_barrier(bar); if (PROBE_BARX && (k) == 2) { for (int r_ = 0; r_ < 10; ++r_) xcd_barrier(bar); } } } while (0)
    LAS unsigned char* ring = F.lds; LAS unsigned char* xl = F.lds + XCH_OFF;
    f16_t* A16 = (f16_t*)(ws + WS_A16); f16_t* Y16 = (f16_t*)(ws + WS_Y16); f16_t* P16 = (f16_t*)(ws + WS_P16);
    float* SS0 = (float*)(F.ctl + CW_SS0); float* SSV = (float*)(F.ctl + CW_SSV); float* SS1 = (float*)(F.ctl + CW_SS1); float* SS2 = (float*)(F.ctl + CW_SS2); float* SS3 = (float*)(F.ctl + CW_SS3);
    float* KMEAN = (float*)(F.ctl + CW_KMEAN);
    const int c = (int)blockIdx.x;

#ifndef PROBE_DUP
#define PROBE_DUP -1
#endif
#define RUNS(k) for (int rep = 0; rep < (((k) == PROBE_DUP) ? 2 : 1); ++rep)
    if (IN(0)) { RUNS(0) p0_prologue(F, args); } SEAM(0);
    if (IN(1)) { { pg8::Gemm g{(const f16_t*)(ws + WS_MEM16), (const f16_t*)(ws + WS_WKV), DM}; pg8::Order S; S.init(2, 2, F.G, (c + 4) % F.G, 0);
        pg8::EpiKV E{(f16_t*)(ws + WS_KM16), (f16_t*)(ws + WS_VM16), (const float*)(F.ctl + CW_SSM), args.in[15]}; pg8::gemm_phase<pg8::EpiKV, true>(ring, xl, g, S, E); }
      RUNS(1) { pg8::Gemm g{A16, (const f16_t*)(ws + WS_WINA), DM}; pg8::Order S; S.init(M / 256, NA / 256, F.G, c, 0);
        pg8::EpiInA E{P16, SS0, SSV, rep > 0}; pg8::gemm_phase<pg8::EpiInA, true>(ring, xl, g, S, E); }
      { int ilo = ((M / 256) * (NA / 256)) % F.G, ihi = F.G - 4; if (ihi - ilo < 8) { ilo = 0; ihi = F.G; }
        if (c >= ilo && c < ihi) { __syncthreads(); p0_late_weights(F, args, (c - ilo) * NWAVES + F.wave, (ihi - ilo) * NWAVES); __syncthreads(); } } } SEAM(1);
#ifndef PROBE_P2
#define PROBE_P2 0
#endif
    if (IN(2)) { mixer_a<true, true>(F, args); if (PROBE_P2 == 1) mixer_a<true, false>(F, args); if (PROBE_P2 == 2) mixer_a<false, true>(F, args); } SEAM(2);
    if (IN(3)) { RUNS(3) { pg8::Gemm g{Y16, (const f16_t*)(ws + WS_WOUTA), DM}; pg8::Order S; S.init(M / 256, DM / 256, F.G, c, 0);
        pg8::EpiRes E{A16, nullptr, SS1, rep > 0, nullptr, 1.0f}; pg8::gemm_phase<pg8::EpiRes, true>(ring, xl, g, S, E); } } SEAM(3);
    float* BNDG = (float*)(ws + WS_Y16);
    if (IN(4)) { RUNS(4) { pg8::Gemm g{A16, (const f16_t*)(ws + WS_WUP0), DM}; pg8::Order S; S.init(M / 256, FF2 / 256, F.G, c, 0);
        pg8::EpiUp E{P16, SS1, args.in[18], args.in[19], BNDG}; pg8::gemm_phase<pg8::EpiUp, true>(ring, xl, g, S, E); }
      if (hi - lo > 1) xcd_barrier(bar);
      ffn_fixup(F, BNDG, args.in[18], args.in[19], P16);
#ifdef PROBE_NULL4
      { pg8::Gemm g{A16, (const f16_t*)(ws + WS_WUP0), DM}; pg8::Order S; S.init(M / 256, FF2 / 256, F.G, c, 0); pg8::EpiNull E{}; pg8::gemm_phase<pg8::EpiNull, true>(ring, xl, g, S, E); }
#endif
    } SEAM(4);
    if (IN(5)) { RUNS(5) { pg8::Gemm g{P16, (const f16_t*)(ws + WS_WDN0), FF}; pg8::Order S; S.init(M / 256, DM / 256, F.G, c, 0);
        pg8::EpiRes E{A16, nullptr, SS2, rep > 0, ws + WS_PO  , 1.0f}; pg8::gemm_phase<pg8::EpiRes, true>(ring, xl, g, S, E); } } SEAM(5);
    if (IN(6)) { RUNS(6) { pg8::Gemm g{(const f16_t*)(ws + WS_PO), (const f16_t*)(ws + WS_WINB), DM / 2};   pg8::Order S; S.init(M / 256, NB / 256, F.G, c, 0);
        pg8::EpiInB E{P16, SS2, args.in[11], args.in[12], KMEAN, rep > 0, 1.0f / (F8_SA * F8_SW)}; pg8::gemm_phase<pg8::EpiInB, true, true>(ring, xl, g, S, E); } } SEAM(6);
#ifndef PROBE_P7
#define PROBE_P7 0
#endif
    if (IN(7)) { moba_select(F, args); xattn_b(F, args); if (PROBE_P7 == 1) moba_select(F, args); if (PROBE_P7 == 2) xattn_b(F, args); } SEAM(7);
#ifndef PROBE_SPARSE_NOENG
#define PROBE_SPARSE_NOENG 0
#endif
#ifndef PROBE_ESTEPS
#define PROBE_ESTEPS 0
#endif
    if (IN(8)) { moba_sparse<true, 8>(F, args, 0); if (PROBE_SPARSE_NOENG) moba_sparse<false, PROBE_ESTEPS>(F, args, 1); else if (PROBE_DUP == 8) moba_sparse<true, 8>(F, args, 1); } SEAM(8);
#ifndef PROBE_OWN
#define PROBE_OWN 0
#endif
    if (IN(9)) { moba_own<true, true, true>(F, args); if (PROBE_OWN == 1) moba_own<true, true, false>(F, args); if (PROBE_OWN == 2) moba_own<false, true, false>(F, args); if (PROBE_OWN == 3) moba_own<true, false, false>(F, args); if (PROBE_OWN == 4) moba_own<false, false, false>(F, args); } SEAM(9);
    if (IN(10)) { RUNS(10) { pg8::Gemm g{Y16, (const f16_t*)(ws + WS_WOUTB), DM / 2};   pg8::Order S; S.init(M / 256, DM / 256, F.G, c, 0);
        pg8::EpiRes E{A16, nullptr, SS3, rep > 0, nullptr, 1.0f / (F8_SY * F8_SW)}; pg8::gemm_phase<pg8::EpiRes, true, true>(ring, xl, g, S, E); } } SEAM(10);
    if (IN(11)) { RUNS(11) { pg8::Gemm g{A16, (const f16_t*)(ws + WS_WUP1), DM}; pg8::Order S; S.init(M / 256, FF2 / 256, F.G, c, 0);
        pg8::EpiUp E{P16, SS3, args.in[18] + 3 * FF2, args.in[19] + FF2, BNDG}; pg8::gemm_phase<pg8::EpiUp, true>(ring, xl, g, S, E); }
      if (hi - lo > 1) xcd_barrier(bar);
      ffn_fixup(F, BNDG, args.in[18] + 3 * FF2, args.in[19] + FF2, P16); } SEAM(11);
    if (IN(12)) { RUNS(12) { pg8::Gemm g{P16, (const f16_t*)(ws + WS_WDN1), FF}; pg8::Order S; S.init(M / 256, DM / 256, F.G, c, 0);
        pg8::EpiRes E{A16, args.out, nullptr, rep > 0, nullptr, 1.0f}; pg8::gemm_phase<pg8::EpiRes, true>(ring, xl, g, S, E); } }
#undef IN
#undef SEAM
}

extern "C" void kernel_launch(void* const* d_in, const int* in_sizes, int n_in, void* d_out, int out_size, void* d_ws, size_t ws_size, hipStream_t stream) {
    static int grid = 0;
    if (grid == 0) {
        if (n_in != 21 || in_sizes[0] != M * DM || out_size != M * DM || ws_size < WS_END) { fprintf(stderr, "kernel_launch: unexpected shapes (n_in %d, in0 %d, out %d, ws %zu); nothing launched\n", n_in, n_in > 0 ? in_sizes[0] : -1, out_size, ws_size); grid = -1; return; }
        int dev = 0, cus = 0;
        if (hipGetDevice(&dev) != hipSuccess || hipDeviceGetAttribute(&cus, hipDeviceAttributeMultiprocessorCount, dev) != hipSuccess) { grid = -1; return; }
        if (hipFuncSetAttribute((const void*)fwd_kernel, hipFuncAttributeMaxDynamicSharedMemorySize, LDS_BYTES) != hipSuccess) { fprintf(stderr, "kernel_launch: hipFuncSetAttribute failed\n"); grid = -1; return; }
        (void)hipGetLastError();
        grid = cus;
    }
    if (grid < 0) return;
    if (hipMemsetAsync((char*)d_ws + WS_CTL, 0, CTL_BYTES, stream) != hipSuccess) return;
    Args a{};
    for (int i = 0; i < 21; ++i) a.in[i] = (const float*)d_in[i];
    a.out = (float*)d_out; a.ws = (unsigned char*)d_ws;
#if MK_ONE_LAUNCH
    a.ph_lo = 0; a.ph_hi = 13;
    hipLaunchKernelGGL(fwd_kernel, dim3(grid), dim3(NWAVES * 64), LDS_BYTES, stream, a);
#else
    for (int p = 0; p < 13; ++p) { a.ph_lo = p; a.ph_hi = p + 1; hipLaunchKernelGGL(fwd_kernel, dim3(grid), dim3(NWAVES * 64), LDS_BYTES, stream, a); }
#endif
}
```

```cpp
#include <hip/hip_runtime.h>
#include <cstdio>
#include <cstdint>

#ifndef MK_ONE_LAUNCH
#define MK_ONE_LAUNCH 1
#endif

#define LAS __attribute__((address_space(3)))
#define GAS __attribute__((address_space(1)))
typedef unsigned short f16_t;
typedef _Float16 h16x8 __attribute__((ext_vector_type(8)));
typedef _Float16 h16x4 __attribute__((ext_vector_type(4)));
typedef _Float16 h16x2 __attribute__((ext_vector_type(2)));
typedef float f32x4 __attribute__((ext_vector_type(4)));
typedef float f32x2 __attribute__((ext_vector_type(2)));
typedef unsigned u32x4 __attribute__((ext_vector_type(4)));
typedef unsigned u32x2 __attribute__((ext_vector_type(2)));
typedef GAS unsigned gu32;

constexpr int BATCH = 2, SEQ = 16384, DM = 1024, M = BATCH * SEQ;
constexpr int MIXW = 768, MEMW = 256, NA = 2 * MIXW + MEMW  , NB = 3 * MIXW + MEMW  ;
constexpr int FF = 2816, FF2 = 5632, NMEM = 256, HD = 64;
constexpr int CHUNK = 128, NGRP = 6, MOBA_H = 12, MOBA_BLK = 256, NBLK = SEQ / MOBA_BLK  ;
constexpr float EPS = 1e-6f;
constexpr int UP_UNITS_PER_BATCH = 69;

constexpr size_t MiB = 1u << 20;
constexpr size_t WS_CTL = 0, CTL_BYTES = 2 * MiB;
constexpr size_t WS_WINA = 2 * MiB, WS_WOUTA = 6 * MiB, WS_WINB = 8 * MiB, WS_WOUTB = 13 * MiB;
constexpr size_t WS_WUP0 = 15 * MiB, WS_WUP1 = 26 * MiB, WS_WDN0 = 37 * MiB, WS_WDN1 = 43 * MiB, WS_KV = 49 * MiB, WS_KM16 = 50 * MiB, WS_VM16 = 51 * MiB, WS_LIST = 52 * MiB, WS_OFFS = 55 * MiB, WS_PL = 56 * MiB, WS_MEM16 = 61 * MiB, WS_WKV = 62 * MiB, WS_W16S = 63 * MiB;
constexpr size_t WS_A16 = 64 * MiB, WS_Y16 = 128 * MiB, WS_P16 = 192 * MiB, WS_PO = 368 * MiB, WS_END = 512 * MiB;
constexpr int CW_TMO = 0, CW_BAR = 4096, CW_QUEUE = 8192;
constexpr int CW_SS0 = 16384, CW_SSV = CW_SS0 + M, CW_SS1 = CW_SSV + M, CW_SS2 = CW_SS1 + M, CW_SS3 = CW_SS2 + M;
constexpr int CW_SSM = CW_SS3 + M;
constexpr int CW_KMEAN = CW_SSM + 512;
static_assert((size_t)(CW_KMEAN + BATCH * MOBA_H * NBLK * HD) * 4 <= CTL_BYTES, "ctl");

constexpr int RING_BYTES = 131072, XCH_OFF = RING_BYTES, XCH_BYTES = 16384, MISC_OFF = 163840 - 256;
constexpr int LDS_BYTES = 163840;
constexpr int NWAVES = 8;

#define LDS_WAIT() asm volatile("s_waitcnt lgkmcnt(0)" ::: "memory")
#define VM_WAIT() asm volatile("s_waitcnt vmcnt(0)" ::: "memory")
#define RLX_AGENT __ATOMIC_RELAXED, __HIP_MEMORY_SCOPE_AGENT

__device__ __forceinline__ unsigned pkh(float lo, float hi) { f32x2 v = {lo, hi}; h16x2 h = __builtin_convertvector(v, h16x2); return __builtin_bit_cast(unsigned, h); }
__device__ __forceinline__ unsigned pk8(float a, float b, float c, float d) { int w = __builtin_amdgcn_cvt_pk_fp8_f32(a, b, 0, false); w = __builtin_amdgcn_cvt_pk_fp8_f32(c, d, w, true); return (unsigned)w; }
constexpr float F8_SA = 8.0f, F8_SW = 512.0f, F8_SY = 32.0f;
__device__ __forceinline__ float h2f(f16_t b) { return (float)__builtin_bit_cast(_Float16, b); }
__device__ __forceinline__ f16_t f2h(float f) { return __builtin_bit_cast(f16_t, (_Float16)f); }
__device__ __forceinline__ float gelu_tanh(float x) {
    const float u = x * (1.0f + 0.044715f * x * x);
    const float e = __builtin_amdgcn_exp2f(u * (-2.0f * 0.7978845608028654f * 1.4426950408889634f));
    return x * __builtin_amdgcn_rcpf(1.0f + e);
}
__device__ __forceinline__ f32x2 gelu_tanh2(f32x2 x) {
    constexpr float C = -2.0f * 0.7978845608028654f * 1.4426950408889634f;
    const f32x2 t = (x * x) * (0.044715f * C) + C;
    const f32x2 a = x * t;
    f32x2 e; e.x = __builtin_amdgcn_exp2f(a.x); e.y = __builtin_amdgcn_exp2f(a.y);
    const f32x2 d = e + 1.0f;
    f32x2 r; r.x = __builtin_amdgcn_rcpf(d.x); r.y = __builtin_amdgcn_rcpf(d.y);
    return x * r;
}
__device__ __forceinline__ float wave_sum(float v) {
#pragma unroll
    for (int o = 1; o < 64; o <<= 1) v += __shfl_xor(v, o);
    return v;
}

namespace pg8 {
constexpr int BM = 256, BK = 64, HALF = 128, HTB = HALF * BK * 2, STAGE_BYTES = 8 * HTB, NXCD = 8, WGM = 8;
__host__ __device__ __forceinline__ int lds_byte(int r, int c) { const int st = (r >> 4) * 2 + (c >> 5), rr = r & 15, cc = c & 31, ob = rr * 64 + cc * 2; return st * 1024 + (ob ^ (((ob >> 9) & 1) << 5)); }
__host__ __device__ __forceinline__ void stage_rc(int b, int& R, int& C) { const int st = b / 1024, sb = b % 1024, swz = sb ^ (((sb >> 9) & 1) << 5); R = (st >> 1) * 16 + swz / 64; C = (st & 1) * 32 + (swz % 64) / 2; }
__host__ __device__ __forceinline__ int perm32(int rho) { const int n = rho >> 4, i = rho & 15; return 8 * (i >> 2) + 4 * n + (i & 3); }

struct Unit { int pm, pn; };
struct Gemm { const f16_t* A; const f16_t* Bt; int K; };

struct Order {
    int nM, nN, nwg, G, c, mode;
    __device__ void init(int nM_, int nN_, int G_, int c_, int mode_) { nM = nM_; nN = nN_; nwg = nM * nN; G = G_; c = c_; mode = mode_; }
    __device__ bool next(int i, Unit& u) const {
        const long L = (long)i * G + c; if (L >= nwg) return false;
        int wgid = (int)L; { const int q = nwg / NXCD, r = nwg % NXCD, xcd = wgid % NXCD, off = wgid / NXCD; wgid = (xcd < r ? xcd * (q + 1) : r * (q + 1) + (xcd - r) * q) + off; }
        const int nig = WGM * nN, gid = wgid / nig, fm = gid * WGM, gsz = (nM - fm) < WGM ? (nM - fm) : WGM;
        u.pm = fm + ((wgid % nig) % gsz); u.pn = (wgid % nig) / gsz; return true;
    }
    __device__ __forceinline__ int arow(int pm) const {
        if (mode == 0) return pm * BM;
        const int b = pm / UP_UNITS_PER_BATCH, i = pm % UP_UNITS_PER_BATCH; int s = (i == 0) ? 0 : 240 * i; if (s > SEQ - 256) s = SEQ - 256; return b * SEQ + s;
    }
    __device__ __forceinline__ int out_lo(int pm) const { return (mode == 0 || (pm % UP_UNITS_PER_BATCH) == 0) ? 0 : 16; }
};

typedef int i32x8 __attribute__((ext_vector_type(8)));
__device__ __forceinline__ i32x8 cat_frag(h16x8 a, h16x8 b) { const u32x4 x = __builtin_bit_cast(u32x4, a), y = __builtin_bit_cast(u32x4, b); return (i32x8){(int)x.x, (int)x.y, (int)x.z, (int)x.w, (int)y.x, (int)y.y, (int)y.z, (int)y.w}; }
template <class Epi, bool ALIGN_EPI, bool FP8 = false>
__device__ __forceinline__ void gemm_phase(LAS unsigned char* lds, LAS unsigned char* xl, const Gemm g, const Order& S, const Epi& E) {
    const int tid = threadIdx.x, wid = __builtin_amdgcn_readfirstlane(tid >> 6), lane = tid & 63, wr = wid >> 2, wc = wid & 3, fr = lane & 15, fq = lane >> 4;
    const int K = g.K, nt = K / BK;
    unsigned voffA[2], voffB[2];
#pragma unroll
    for (int i = 0; i < 2; ++i) { int R, C; stage_rc(tid * 16 + i * 8192, R, C); const int Rb = Epi::PERM ? ((R & ~31) + perm32(R & 31)) : R;
        const int Ra = Epi::PERMA ? ((R & ~63) + 4 * (R & 15) + ((R >> 4) & 3)) : R;
        voffA[i] = (unsigned)(Ra * K + C) * 2u; voffB[i] = (unsigned)(Rb * K + C) * 2u; }
    const size_t kstep = (size_t)(BK * 2);
    const size_t hstep = (size_t)HALF * K * 2;
    const size_t tstep = 2 * hstep;
    const size_t rstep = (size_t)K * 2;
    const unsigned ldsw = (unsigned)wid * 1024u;
    const int aoff = lds_byte(wr * 64 + fr, fq * 8), boff = lds_byte(wc * 32 + fr, fq * 8);
#define PG8_SA(b, h) (((b) * 2 + (h)) * HTB)
#define PG8_SB(b, h) ((4 + (b) * 2 + (h)) * HTB)
#define PG8_STAGE(bufoff, gbase, voff) do { _Pragma("unroll") for (int _i = 0; _i < 2; ++_i) \
        __builtin_amdgcn_global_load_lds((const unsigned*)((const char*)(gbase) + (voff)[_i]), (LAS unsigned*)(lds + (bufoff) + ldsw + _i * 8192), 16, 0, 0); } while (0)
#define PG8_LDA(dst, b, h) do { _Pragma("unroll") for (int m = 0; m < 4; ++m) _Pragma("unroll") for (int k = 0; k < 2; ++k) dst[m][k] = *(const LAS h16x8*)(lds + PG8_SA(b, h) + aoff + m * 2048 + k * 1024); } while (0)
#define PG8_LDB(dst, b, h) do { _Pragma("unroll") for (int n = 0; n < 2; ++n) _Pragma("unroll") for (int k = 0; k < 2; ++k) dst[n][k] = *(const LAS h16x8*)(lds + PG8_SB(b, h) + boff + n * 2048 + k * 1024); } while (0)
#define PG8_MMA(ai, bj, At, Bt) do { __builtin_amdgcn_s_setprio(1); _Pragma("unroll") for (int m = 0; m < 4; ++m) _Pragma("unroll") for (int n = 0; n < 2; ++n) { \
        if constexpr (FP8) asm volatile("v_mfma_scale_f32_16x16x128_f8f6f4 %0, %1, %2, %0, %3, %3 op_sel_hi:[0,0,0]" : "+v"(acc[ai][bj][m][n]) : "v"(cat_frag(Bt[n][0], Bt[n][1])), "v"(cat_frag(At[m][0], At[m][1])), "v"(one8)); \
        else { _Pragma("unroll") for (int k = 0; k < 2; ++k) acc[ai][bj][m][n] = __builtin_amdgcn_mfma_f32_16x16x32_f16(Bt[n][k], At[m][k], acc[ai][bj][m][n], 0, 0, 0); } } __builtin_amdgcn_s_setprio(0); } while (0)
#define PG8_WAIT_V(n) asm volatile("s_waitcnt vmcnt(" #n ")" ::: "memory")
#define PG8_WAIT_L(n) asm volatile("s_waitcnt lgkmcnt(" #n ")" ::: "memory")
#define PG8_BAR __builtin_amdgcn_s_barrier()
#define PG8_SCHED __builtin_amdgcn_sched_barrier(0)
    Unit cur, nxt; int ui = 0;
    if (!S.next(0, cur)) return;
    int one8 = 0x7F7F7F7F; asm volatile("" : "+v"(one8));
    f32x4 acc[2][2][4][2];
#pragma unroll
    for (int a = 0; a < 2; ++a)
#pragma unroll
        for (int b = 0; b < 2; ++b)
#pragma unroll
            for (int m = 0; m < 4; ++m)
#pragma unroll
                for (int n = 0; n < 2; ++n) acc[a][b][m][n] = (f32x4){0.f, 0.f, 0.f, 0.f};
    h16x8 At[4][2], B0[2][2], B1[2][2];
    const char* cA = (const char*)g.A + (size_t)S.arow(cur.pm) * rstep; const char* cB = (const char*)g.Bt + (size_t)cur.pn * tstep;
    PG8_STAGE(PG8_SB(0, 0), cB, voffB); PG8_STAGE(PG8_SB(0, 1), cB + hstep, voffB); PG8_STAGE(PG8_SA(0, 0), cA, voffA); PG8_STAGE(PG8_SA(0, 1), cA + hstep, voffA);
    if (wr == 1) PG8_BAR;
    PG8_WAIT_V(2); PG8_BAR;
    PG8_STAGE(PG8_SB(1, 0), cB + kstep, voffB); PG8_STAGE(PG8_SA(1, 0), cA + kstep, voffA); PG8_STAGE(PG8_SB(1, 1), cB + hstep + kstep, voffB);
    PG8_WAIT_V(6); PG8_BAR;
    for (;;) {
        const bool has_next = S.next(ui + 1, nxt);
        E.prefetch(cur, S, xl, ui, wid, lane);
        const char* nA = has_next ? (const char*)g.A + (size_t)S.arow(nxt.pm) * rstep : cA; const char* nB = has_next ? (const char*)g.Bt + (size_t)nxt.pn * tstep : cB;
#pragma unroll 1
        for (int t = 0; t < nt; t += 2) {
            const bool last = (t == nt - 2);
            const char* a1 = cA + (size_t)(t + 1) * kstep;
            const char* a2 = last ? nA : cA + (size_t)(t + 2) * kstep; const char* b2 = last ? nB : cB + (size_t)(t + 2) * kstep;
            const char* a3 = a2 + kstep; const char* b3 = b2 + kstep;
            PG8_LDB(B0, 0, 0); PG8_LDB(B1, 0, 1); PG8_SCHED; PG8_LDA(At, 0, 0); PG8_STAGE(PG8_SA(1, 1), a1 + hstep, voffA);
            PG8_WAIT_V(8); PG8_WAIT_L(0); PG8_BAR; PG8_MMA(0, 0, At, B0); PG8_MMA(0, 1, At, B1); PG8_BAR; PG8_SCHED;
            PG8_LDA(At, 0, 1); PG8_STAGE(PG8_SB(0, 0), b2, voffB); PG8_STAGE(PG8_SB(0, 1), b2 + hstep, voffB); PG8_STAGE(PG8_SA(0, 0), a2, voffA);
            PG8_WAIT_V(8); PG8_WAIT_L(0); PG8_BAR; PG8_MMA(1, 0, At, B0); PG8_MMA(1, 1, At, B1); PG8_BAR; PG8_SCHED;
            PG8_LDB(B0, 1, 0); PG8_LDB(B1, 1, 1); PG8_SCHED; PG8_LDA(At, 1, 0); PG8_STAGE(PG8_SA(0, 1), a2 + hstep, voffA);
            PG8_WAIT_V(8); PG8_WAIT_L(0); PG8_BAR; PG8_MMA(0, 0, At, B0); PG8_MMA(0, 1, At, B1); PG8_BAR; PG8_SCHED;
            PG8_LDA(At, 1, 1); PG8_STAGE(PG8_SB(1, 0), b3, voffB); PG8_STAGE(PG8_SB(1, 1), b3 + hstep, voffB); PG8_STAGE(PG8_SA(1, 0), a3, voffA);
            PG8_WAIT_V(8); PG8_WAIT_L(0); PG8_BAR; PG8_MMA(1, 0, At, B0); PG8_MMA(1, 1, At, B1); PG8_BAR; PG8_SCHED;
        }
        if constexpr (ALIGN_EPI) { if (wr == 0) PG8_BAR; }
        if constexpr (FP8) asm volatile("s_nop 15\n\ts_nop 15" ::: "memory");
        E(acc, cur, S, wr, wc, fr, fq, xl, ui);
        if (!has_next) break;
#pragma unroll
        for (int a = 0; a < 2; ++a)
#pragma unroll
            for (int b = 0; b < 2; ++b)
#pragma unroll
                for (int m = 0; m < 4; ++m)
#pragma unroll
                    for (int n = 0; n < 2; ++n) acc[a][b][m][n] = (f32x4){0.f, 0.f, 0.f, 0.f};
        cur = nxt; cA = nA; cB = nB; ++ui;
        if constexpr (ALIGN_EPI) { if (wr == 1) PG8_BAR; }
    }
    PG8_WAIT_V(0);
    if constexpr (!ALIGN_EPI) { if (wr == 0) PG8_BAR; }
    PG8_BAR;
#undef PG8_SA
#undef PG8_SB
#undef PG8_STAGE
#undef PG8_LDA
#undef PG8_LDB
#undef PG8_MMA
#undef PG8_WAIT_V
#undef PG8_WAIT_L
#undef PG8_BAR
#undef PG8_SCHED
}

struct EpiInA {
    static constexpr bool PERM = true; static constexpr bool PERMA = false;
    f16_t* P; const float* ss_in; float* ssv; bool dry;
    __device__ __forceinline__ void prefetch(const Unit&, const Order&, LAS unsigned char*, int, int, int) const {}
    __device__ __forceinline__ void operator()(f32x4 (&acc)[2][2][4][2], const Unit& u, const Order& S, int wr, int wc, int fr_, int fq_, LAS unsigned char*, int) const {
        int fr = fr_, fq = fq_; asm volatile("" : "+v"(fr), "+v"(fq));
        const int row0 = u.pm * BM + wr * 64 + fr, col0 = u.pn * BM + wc * 32 + 8 * fq;
        const bool act = u.pn < 6, stat = (u.pn >= 3 && u.pn < 6);
#pragma unroll
        for (int ai = 0; ai < 2; ++ai)
#pragma unroll
            for (int m = 0; m < 4; ++m) {
                const int row = row0 + ai * HALF + m * 16;
                const float sc = __builtin_amdgcn_rsqf(ss_in[row] * (1.0f / DM) + EPS);
                float sq = 0.f;
#pragma unroll
                for (int bj = 0; bj < 2; ++bj) {
                    f32x4 v0 = acc[ai][bj][m][0] * sc, v1 = acc[ai][bj][m][1] * sc;
                    if (act) { const f32x2 a0 = gelu_tanh2((f32x2){v0[0], v0[1]}), a1 = gelu_tanh2((f32x2){v0[2], v0[3]}), a2 = gelu_tanh2((f32x2){v1[0], v1[1]}), a3 = gelu_tanh2((f32x2){v1[2], v1[3]});
                        v0 = (f32x4){a0.x, a0.y, a1.x, a1.y}; v1 = (f32x4){a2.x, a2.y, a3.x, a3.y}; }
                    sq += (v0[0] * v0[0] + v0[1] * v0[1]) + (v0[2] * v0[2] + v0[3] * v0[3]) + (v1[0] * v1[0] + v1[1] * v1[1]) + (v1[2] * v1[2] + v1[3] * v1[3]);
                    u32x4 w; w.x = pkh(v0[0], v0[1]); w.y = pkh(v0[2], v0[3]); w.z = pkh(v1[0], v1[1]); w.w = pkh(v1[2], v1[3]);
                    *(u32x4*)(P + (size_t)row * NA + col0 + bj * HALF) = w;
                }
                if (stat && !dry) { sq += __shfl_xor(sq, 16); sq += __shfl_xor(sq, 32); if (fq == 0) atomicAdd(ssv + row, sq); }
            }
    }
};
struct EpiRes {
    static constexpr bool PERM = true; static constexpr bool PERMA = false;
    f16_t* h16; float* out32; float* ss_out; bool dry; unsigned char* h8; float pre;
    __device__ __forceinline__ void prefetch(const Unit&, const Order&, LAS unsigned char*, int, int, int) const {}
    __device__ __forceinline__ void operator()(f32x4 (&acc)[2][2][4][2], const Unit& u, const Order& S, int wr, int wc, int fr_, int fq_, LAS unsigned char*, int) const {
        int fr = fr_, fq = fq_; asm volatile("" : "+v"(fr), "+v"(fq));
        const int row0 = u.pm * BM + wr * 64 + fr, col0 = u.pn * BM + wc * 32 + 8 * fq;
#pragma unroll
        for (int ai = 0; ai < 2; ++ai)
#pragma unroll
            for (int m = 0; m < 4; ++m) {
                const int row = row0 + ai * HALF + m * 16; const size_t off = (size_t)row * DM + col0;
                float sq = 0.f;
#pragma unroll
                for (int bj = 0; bj < 2; ++bj) {
                    const h16x8 bs = *(const h16x8*)(h16 + off + bj * HALF);
                    f32x4 o0 = acc[ai][bj][m][0] * pre, o1 = acc[ai][bj][m][1] * pre;
#pragma unroll
                    for (int e = 0; e < 4; ++e) { o0[e] += (float)bs[e]; o1[e] += (float)bs[4 + e]; }
                    if (out32) { if (!dry) { __builtin_nontemporal_store(o0, (f32x4*)(out32 + off + bj * HALF)); __builtin_nontemporal_store(o1, (f32x4*)(out32 + off + bj * HALF + 4)); } }
                    else if (!dry) {
                        sq += (o0[0] * o0[0] + o0[1] * o0[1]) + (o0[2] * o0[2] + o0[3] * o0[3]) + (o1[0] * o1[0] + o1[1] * o1[1]) + (o1[2] * o1[2] + o1[3] * o1[3]);
                        u32x4 w; w.x = pkh(o0[0], o0[1]); w.y = pkh(o0[2], o0[3]); w.z = pkh(o1[0], o1[1]); w.w = pkh(o1[2], o1[3]);
                        *(u32x4*)(h16 + off + bj * HALF) = w;
                        if (h8) { u32x2 q; q.x = pk8(o0[0] * F8_SA, o0[1] * F8_SA, o0[2] * F8_SA, o0[3] * F8_SA); q.y = pk8(o1[0] * F8_SA, o1[1] * F8_SA, o1[2] * F8_SA, o1[3] * F8_SA); *(u32x2*)(h8 + off + bj * HALF) = q; } }
                }
                if (!out32 && !dry) { sq += __shfl_xor(sq, 16); sq += __shfl_xor(sq, 32); if (fq == 0) atomicAdd(ss_out + row, sq); }
            }
    }
};
__device__ __forceinline__ float dpp_ror1(float v) { return __builtin_bit_cast(float, __builtin_amdgcn_mov_dpp(__builtin_bit_cast(int, v), 0x121, 0xf, 0xf, false)); }
__device__ __forceinline__ float dpp_ror2(float v) { return __builtin_bit_cast(float, __builtin_amdgcn_mov_dpp(__builtin_bit_cast(int, v), 0x122, 0xf, 0xf, false)); }
__device__ __forceinline__ float dpp_shr1_keep(float keep, float v) { return __builtin_bit_cast(float, __builtin_amdgcn_update_dpp(__builtin_bit_cast(int, keep), __builtin_bit_cast(int, v), 0x111, 0xf, 0xf, false)); }
__device__ __forceinline__ float dpp_shr2_keep(float keep, float v) { return __builtin_bit_cast(float, __builtin_amdgcn_update_dpp(__builtin_bit_cast(int, keep), __builtin_bit_cast(int, v), 0x112, 0xf, 0xf, false)); }
struct EpiUp {
    static constexpr bool PERM = false;
    static constexpr bool PERMA = true;
    f16_t* U; const float* ss_in; const float* cw; const float* cb; float* bnd_g;
    __device__ __forceinline__ void prefetch(const Unit& u, const Order& S, LAS unsigned char* xl, int ui, int wid, int lane) const {
        if (wid >= 5) return;
        LAS unsigned char* dst = xl + 8192 + (ui & 1) * 5120 + wid * 1024;
        const float* src;
        if (wid < 3) src = cw + (size_t)wid * FF2 + (lane >> 5) * FF + u.pn * HALF + 4 * (lane & 31);
        else if (wid == 3) src = cb + (lane >> 5) * FF + u.pn * HALF + 4 * (lane & 31);
        else src = ss_in + S.arow(u.pm) + 4 * lane;
        __builtin_amdgcn_global_load_lds((const unsigned*)src, (LAS unsigned*)dst, 16, 0, 0);
    }
    __device__ __forceinline__ void operator()(f32x4 (&acc)[2][2][4][2], const Unit& u, const Order& S, int wr, int wc, int fr_, int fq_, LAS unsigned char* xl, int ui) const {
        int fr = fr_, fq = fq_; asm volatile("" : "+v"(fr), "+v"(fq));
        const int rs = S.arow(u.pm), lo = 2;
        const int trow0 = wr * 64 + 4 * fr;
        LAS const float* cst = (LAS const float*)(xl + 8192 + (ui & 1) * 5120);
#pragma unroll
        for (int ai = 0; ai < 2; ++ai) {
            const f32x4 ss4 = *(const LAS f32x4*)(cst + 1024 + trow0 + ai * HALF);
#pragma unroll
            for (int m = 0; m < 4; ++m) {
                const float sc = __builtin_amdgcn_rsqf(ss4[m] * (1.0f / DM) + EPS);
#pragma unroll
                for (int bj = 0; bj < 2; ++bj)
#pragma unroll
                    for (int n = 0; n < 2; ++n) acc[ai][bj][m][n] *= sc;
            }
        }
        LAS float* bnd = (LAS float*)xl;
        const int tcol = wc * 32 + 4 * fq;
        if (fr == 15) {
#pragma unroll
            for (int ai = 0; ai < 2; ++ai)
#pragma unroll
                for (int bj = 0; bj < 2; ++bj)
#pragma unroll
                    for (int n = 0; n < 2; ++n) { *(LAS f32x4*)(bnd + ((2 * ai + wr) * 2 + 0) * 256 + bj * HALF + tcol + 16 * n) = acc[ai][bj][2][n]; *(LAS f32x4*)(bnd + ((2 * ai + wr) * 2 + 1) * 256 + bj * HALF + tcol + 16 * n) = acc[ai][bj][3][n]; }
        }
        { float* bq = bnd_g + (size_t)(u.pm * S.nN + u.pn) * 1024 + tcol;
          if (wr == 0 && fr == 0) {
#pragma unroll
              for (int bj = 0; bj < 2; ++bj)
#pragma unroll
                  for (int n = 0; n < 2; ++n) { *(f32x4*)(bq + 0 * 256 + bj * HALF + 16 * n) = acc[0][bj][0][n]; *(f32x4*)(bq + 1 * 256 + bj * HALF + 16 * n) = acc[0][bj][1][n]; } }
          if (wr == 1 && fr == 15) {
#pragma unroll
              for (int bj = 0; bj < 2; ++bj)
#pragma unroll
                  for (int n = 0; n < 2; ++n) { *(f32x4*)(bq + 2 * 256 + bj * HALF + 16 * n) = acc[1][bj][2][n]; *(f32x4*)(bq + 3 * 256 + bj * HALF + 16 * n) = acc[1][bj][3][n]; } } }
        LDS_WAIT(); __builtin_amdgcn_s_barrier(); asm volatile("" ::: "memory");
#pragma unroll
        for (int n = 0; n < 2; ++n) {
            f32x4 w0[2], w1[2], w2[2], bb[2];
#pragma unroll
            for (int bj = 0; bj < 2; ++bj) { const int cc = bj * HALF + tcol + 16 * n;
                w0[bj] = *(const LAS f32x4*)(cst + cc); w1[bj] = *(const LAS f32x4*)(cst + 256 + cc); w2[bj] = *(const LAS f32x4*)(cst + 512 + cc); bb[bj] = *(const LAS f32x4*)(cst + 768 + cc); }
#pragma unroll
            for (int ai = 0; ai < 2; ++ai) {
                const int g = 2 * ai + wr;
                f32x4 h[4][2];
#pragma unroll
                for (int bj = 0; bj < 2; ++bj) {
                    f32x4 r63 = {0.f, 0.f, 0.f, 0.f}, r62 = r63;
                    if (g > 0) { r62 = *(const LAS f32x4*)(bnd + ((g - 1) * 2 + 0) * 256 + bj * HALF + tcol + 16 * n); r63 = *(const LAS f32x4*)(bnd + ((g - 1) * 2 + 1) * 256 + bj * HALF + tcol + 16 * n); }
                    const f32x4 x0 = acc[ai][bj][0][n], x1 = acc[ai][bj][1][n], x2 = acc[ai][bj][2][n], x3 = acc[ai][bj][3][n];
                    f32x4 pm1, pm2;
#pragma unroll
                    for (int e = 0; e < 4; ++e) { pm1[e] = dpp_shr1_keep(r63[e], x3[e]); pm2[e] = dpp_shr1_keep(r62[e], x2[e]); }
                    h[0][bj] = __builtin_elementwise_fma(w0[bj], pm2, __builtin_elementwise_fma(w1[bj], pm1, __builtin_elementwise_fma(w2[bj], x0, bb[bj])));
                    h[1][bj] = __builtin_elementwise_fma(w0[bj], pm1, __builtin_elementwise_fma(w1[bj], x0, __builtin_elementwise_fma(w2[bj], x1, bb[bj])));
                    h[2][bj] = __builtin_elementwise_fma(w0[bj], x0, __builtin_elementwise_fma(w1[bj], x1, __builtin_elementwise_fma(w2[bj], x2, bb[bj])));
                    h[3][bj] = __builtin_elementwise_fma(w0[bj], x1, __builtin_elementwise_fma(w1[bj], x2, __builtin_elementwise_fma(w2[bj], x3, bb[bj])));
                }
#pragma unroll
                for (int m = 0; m < 4; ++m) {
                    f32x4 o; { const f32x2 g0 = gelu_tanh2((f32x2){h[m][0][0], h[m][0][1]}) * (f32x2){h[m][1][0], h[m][1][1]}, g1 = gelu_tanh2((f32x2){h[m][0][2], h[m][0][3]}) * (f32x2){h[m][1][2], h[m][1][3]}; o = (f32x4){g0.x, g0.y, g1.x, g1.y}; }
                    const int trow = trow0 + ai * HALF + m;
                    if (trow >= lo) { u32x2 pk; pk.x = pkh(o[0], o[1]); pk.y = pkh(o[2], o[3]); *(u32x2*)(U + (size_t)(rs + trow) * FF + u.pn * HALF + tcol + 16 * n) = pk; }
                }
            }
        }
    }
};
struct EpiInB {
    static constexpr bool PERM = true; static constexpr bool PERMA = false;
    f16_t* P; const float* ss_in; const float* gq; const float* gk; float* kmean; bool dry; float pre;
    __device__ __forceinline__ void prefetch(const Unit&, const Order&, LAS unsigned char*, int, int, int) const {}
    __device__ __forceinline__ void operator()(f32x4 (&acc)[2][2][4][2], const Unit& u, const Order& S, int wr, int wc, int fr_, int fq_, LAS unsigned char*, int) const {
        int fr = fr_, fq = fq_; asm volatile("" : "+v"(fr), "+v"(fq));
        const int row0 = u.pm * BM + wr * 64 + fr, colh = u.pn * BM + wc * 64;
        const bool nrm = u.pn < 6, isk = (u.pn >= 3 && u.pn < 6);
        f32x4 gv[2][2];
#pragma unroll
        for (int bj = 0; bj < 2; ++bj)
#pragma unroll
            for (int n = 0; n < 2; ++n) gv[bj][n] = nrm ? *(const f32x4*)((isk ? gk : gq) + 32 * bj + 8 * fq + 4 * n) : (f32x4){1.f, 1.f, 1.f, 1.f};
        f32x4 ks[2][2];
#pragma unroll
        for (int bj = 0; bj < 2; ++bj)
#pragma unroll
            for (int n = 0; n < 2; ++n) ks[bj][n] = (f32x4){0.f, 0.f, 0.f, 0.f};
#pragma unroll
        for (int ai = 0; ai < 2; ++ai)
#pragma unroll
            for (int m = 0; m < 4; ++m) {
                const int row = row0 + ai * HALF + m * 16;
                const float sc = __builtin_amdgcn_rsqf(ss_in[row] * (1.0f / DM) + EPS) * pre;
                f32x4 v[2][2]; float sq = 0.f;
#pragma unroll
                for (int bj = 0; bj < 2; ++bj)
#pragma unroll
                    for (int n = 0; n < 2; ++n) { v[bj][n] = acc[ai][bj][m][n] * sc; const f32x4 t = v[bj][n]; sq += (t[0] * t[0] + t[1] * t[1]) + (t[2] * t[2] + t[3] * t[3]); }
                float rn = 1.f;
                if (nrm) { sq += __shfl_xor(sq, 16); sq += __shfl_xor(sq, 32); rn = __builtin_amdgcn_rsqf(sq * (1.0f / HD) + EPS); }
#pragma unroll
                for (int bj = 0; bj < 2; ++bj) {
                    const f32x4 a = v[bj][0] * rn * gv[bj][0], b = v[bj][1] * rn * gv[bj][1];
                    ks[bj][0] += a; ks[bj][1] += b;
                    u32x4 w; w.x = pkh(a[0], a[1]); w.y = pkh(a[2], a[3]); w.z = pkh(b[0], b[1]); w.w = pkh(b[2], b[3]);
                    *(u32x4*)(P + (size_t)row * NB + colh + 32 * bj + 8 * fq) = w;
                }
            }
        if (isk && !dry) {
            const int b = u.pm / NBLK, blk = u.pm % NBLK, h = (u.pn - 3) * 4 + wc;
            float* dst = kmean + ((size_t)(b * MOBA_H + h) * NBLK + blk) * HD;
#pragma unroll
            for (int bj = 0; bj < 2; ++bj)
#pragma unroll
                for (int n = 0; n < 2; ++n)
#pragma unroll
                    for (int e = 0; e < 4; ++e) {
                        float s = ks[bj][n][e];
                        s += __shfl_xor(s, 1); s += __shfl_xor(s, 2); s += __shfl_xor(s, 4); s += __shfl_xor(s, 8);
                        if (fr == 0) atomicAdd(dst + 32 * bj + 8 * fq + 4 * n + e, s);
                    }
        }
    }
};
struct EpiKV {
    static constexpr bool PERM = true; static constexpr bool PERMA = false;
    f16_t* KM; f16_t* VM; const float* ss_in; const float* gkm;
    __device__ __forceinline__ void prefetch(const Unit&, const Order&, LAS unsigned char*, int, int, int) const {}
    __device__ __forceinline__ void operator()(f32x4 (&acc)[2][2][4][2], const Unit& u, const Order& S, int wr, int wc, int fr_, int fq_, LAS unsigned char*, int) const {
        int fr = fr_, fq = fq_; asm volatile("" : "+v"(fr), "+v"(fq));
        const bool isk = (u.pn == 0);
        f16_t* dst = (isk ? KM : VM) + (size_t)(u.pm * 4 + wc) * NMEM * HD;
        f32x4 gv[2][2];
#pragma unroll
        for (int bj = 0; bj < 2; ++bj)
#pragma unroll
            for (int n = 0; n < 2; ++n) gv[bj][n] = isk ? *(const f32x4*)(gkm + 32 * bj + 8 * fq + 4 * n) : (f32x4){1.f, 1.f, 1.f, 1.f};
#pragma unroll
        for (int ai = 0; ai < 2; ++ai)
#pragma unroll
            for (int m = 0; m < 4; ++m) {
                const int key = ai * HALF + wr * 64 + m * 16 + fr;
                const float sc = __builtin_amdgcn_rsqf(ss_in[u.pm * BM + key] * (1.0f / DM) + EPS);
                f32x4 v[2][2]; float sq = 0.f;
#pragma unroll
                for (int bj = 0; bj < 2; ++bj)
#pragma unroll
                    for (int n = 0; n < 2; ++n) { v[bj][n] = acc[ai][bj][m][n] * sc; const f32x4 t = v[bj][n]; sq += (t[0] * t[0] + t[1] * t[1]) + (t[2] * t[2] + t[3] * t[3]); }
                float rn = 1.f;
                if (isk) { sq += __shfl_xor(sq, 16); sq += __shfl_xor(sq, 32); rn = __builtin_amdgcn_rsqf(sq * (1.0f / HD) + EPS); }
#pragma unroll
                for (int bj = 0; bj < 2; ++bj) {
                    const f32x4 a = v[bj][0] * rn * gv[bj][0], b = v[bj][1] * rn * gv[bj][1];
                    u32x4 w; w.x = pkh(a[0], a[1]); w.y = pkh(a[2], a[3]); w.z = pkh(b[0], b[1]); w.w = pkh(b[2], b[3]);
                    *(u32x4*)(dst + (size_t)key * HD + 32 * bj + 8 * fq) = w;
                }
            }
    }
};
struct EpiNull {
    static constexpr bool PERM = true; static constexpr bool PERMA = false;
    __device__ __forceinline__ void prefetch(const Unit&, const Order&, LAS unsigned char*, int, int, int) const {}
    __device__ __forceinline__ void operator()(f32x4 (&acc)[2][2][4][2], const Unit& u, const Order& S, int wr, int wc, int fr_, int fq_, LAS unsigned char*, int) const {
#pragma unroll
        for (int ai = 0; ai < 2; ++ai)
#pragma unroll
            for (int bj = 0; bj < 2; ++bj)
#pragma unroll
                for (int m = 0; m < 4; ++m)
#pragma unroll
                    for (int n = 0; n < 2; ++n) asm volatile("" :: "v"(acc[ai][bj][m][n]));
    }
};
}

#define XB_TMO      128
#define XB_XCNT(j)  (256  + 64 * (j))
#define XB_XSUB(j)  (1280 + 64 * (j))
#define XB_XGEN(j)  (2304 + 64 * (j))
#define XB_TOP      3328
#define XB_TOPGEN   3392
#define XCD_BAR_WORDS 3456
#define XB_SPIN_CAP (1u << 18)
__device__ __forceinline__ unsigned xb_ld(unsigned* p)              { return __hip_atomic_load(p, __ATOMIC_RELAXED, __HIP_MEMORY_SCOPE_AGENT); }
__device__ __forceinline__ unsigned xb_add(unsigned* p, unsigned v) { return __hip_atomic_fetch_add(p, v, __ATOMIC_RELAXED, __HIP_MEMORY_SCOPE_AGENT); }
__device__ __forceinline__ unsigned xb_xcc_id() { return (unsigned)__builtin_amdgcn_s_getreg((3 << 11) | 20) & 0xFu; }
#define XB_SPIN(cond, bar) do { unsigned _sp = 0; while (cond) { __builtin_amdgcn_s_sleep(1); \
    if ((++_sp & 255u) == 0u) { if (xb_ld(&(bar)[XB_TMO])) break; if (_sp > XB_SPIN_CAP) { atomicAdd(&(bar)[XB_TMO], 1u); break; } } } } while (0)
struct XcdBarrier { unsigned* bar; unsigned x; volatile LAS unsigned* st; };
__device__ __forceinline__ XcdBarrier xcd_barrier_post(unsigned* bar, volatile LAS unsigned* st) {
    XcdBarrier b; b.bar = bar; b.x = xb_xcc_id(); b.st = st;
    if (threadIdx.x == 0) (void)xb_add(&bar[XB_XCNT(b.x)], 1u);
    return b;
}
__device__ __forceinline__ void xcd_barrier_complete(unsigned* bar, unsigned x, unsigned& nloc, unsigned& nx) {
    const unsigned G = gridDim.x * gridDim.y * gridDim.z;
    unsigned sum, cnt, mine, sp = 0u;
    for (;;) {
        sum = 0u; cnt = 0u; mine = 0u;
#pragma unroll
        for (unsigned j = 0; j < 16; ++j) { const unsigned c = xb_ld(&bar[XB_XCNT(j)]); sum += c; cnt += (c > 0u) ? 1u : 0u; mine = (j == x) ? c : mine; }
        if (sum == G) break;
        __builtin_amdgcn_s_sleep(1);
        if ((++sp & 255u) == 0u) { if (xb_ld(&bar[XB_TMO])) break; if (sp > XB_SPIN_CAP) { atomicAdd(&bar[XB_TMO], 1u); break; } }
    }
    nloc = mine > 0u ? mine : 1u; nx = cnt > 0u ? cnt : 1u;
}
__device__ __forceinline__ void xcd_barrier(const XcdBarrier& b) {
    asm volatile("s_waitcnt vmcnt(0)" ::: "memory");
    __syncthreads();
    if (threadIdx.x == 0) {
        unsigned* bar = b.bar;
        __builtin_amdgcn_s_waitcnt(0);
        unsigned nloc = b.st[0], nx = b.st[1];
        if (nloc == 0u) { xcd_barrier_complete(bar, b.x, nloc, nx); b.st[0] = nloc; b.st[1] = nx; }
        const unsigned old = xb_add(&bar[XB_XSUB(b.x)], 1u);
        const unsigned gen = old / nloc;
        if (old + 1u == (gen + 1u) * nloc) {
            __builtin_amdgcn_fence(__ATOMIC_RELEASE, "agent");
            asm volatile("s_waitcnt vmcnt(0)" ::: "memory");
            const unsigned og = xb_add(&bar[XB_TOP], 1u);
            const unsigned tg = og / nx;
            if (og + 1u == (tg + 1u) * nx) xb_add(&bar[XB_TOPGEN], 1u);
            else XB_SPIN(xb_ld(&bar[XB_TOPGEN]) == tg, bar);
            __builtin_amdgcn_fence(__ATOMIC_ACQUIRE, "agent");
            xb_add(&bar[XB_XGEN(b.x)], 1u);
            asm volatile("s_waitcnt vmcnt(0)" ::: "memory");
        } else {
            XB_SPIN(xb_ld(&bar[XB_XGEN(b.x)]) == gen, bar);
            __builtin_amdgcn_fence(__ATOMIC_ACQUIRE, "agent");
            asm volatile("s_waitcnt vmcnt(0)" ::: "memory");
        }
    }
    __syncthreads();
}

struct Args { const float* in[21]; float* out; unsigned char* ws; int ph_lo, ph_hi; };
struct Frame {
    LAS unsigned char* lds; volatile LAS unsigned* MISC; gu32* ctl;
    int tid, lane, wave, vcu, G;
};

template <bool FP8>
__device__ __forceinline__ void p0_transpose_item(const float* W, int K, int N, f16_t* WT, const float* gain, LAS float* scr, int k0, int n0, int dst0, int lane) {
    { f32x4 v[8];
#pragma unroll
        for (int i = 0; i < 8; ++i) v[i] = __builtin_nontemporal_load((const f32x4*)(W + (size_t)(k0 + (lane >> 3) + 8 * i) * N + n0 + 4 * (lane & 7)));
#pragma unroll
        for (int i = 0; i < 8; ++i) { const int kk = (lane >> 3) + 8 * i; const float gsc = (gain ? gain[k0 + kk] : 1.0f) * (FP8 ? F8_SW : 1.0f);
#pragma unroll
            for (int e = 0; e < 4; ++e) scr[kk * 33 + 4 * (lane & 7) + e] = v[i][e] * gsc; } }
    LDS_WAIT(); asm volatile("" ::: "memory");
    const int c = lane & 7;
#pragma unroll
    for (int j = 0; j < 4; ++j) { const int n = (lane >> 3) + 8 * j; const LAS float* s = scr + (8 * c) * 33 + n;
        if constexpr (FP8) { u32x2 o; o.x = pk8(s[0 * 33], s[1 * 33], s[2 * 33], s[3 * 33]); o.y = pk8(s[4 * 33], s[5 * 33], s[6 * 33], s[7 * 33]);
            *(GAS u32x2*)((unsigned char*)WT + (size_t)(dst0 + n) * K + k0 + 8 * c) = o; }
        else { u32x4 o; o.x = pkh(s[0 * 33], s[1 * 33]); o.y = pkh(s[2 * 33], s[3 * 33]); o.z = pkh(s[4 * 33], s[5 * 33]); o.w = pkh(s[6 * 33], s[7 * 33]);
            *(GAS u32x4*)(WT + (size_t)(dst0 + n) * K + k0 + 8 * c) = o; } }
    LDS_WAIT(); asm volatile("" ::: "memory");
}
__device__ __forceinline__ int map_ident(int n0) { return n0; }
__device__ __forceinline__ int map_heads(int n0) { const int t = n0 >> 8, l = n0 & 255, wc = l >> 6, bj = (l >> 5) & 1; return (t << 8) + 128 * bj + 32 * wc; }
__device__ __forceinline__ int map_up(int n0) { const int bj = n0 >= FF ? 1 : 0, j = n0 - bj * FF; return 256 * (j >> 7) + 128 * bj + (j & 127); }

template <int MAP, bool FP8 = false>
__device__ __forceinline__ void p0_matrix(const Frame& F, const float* W, int K, int N, f16_t* WT, const float* gain, int& base, int gw, int NGW, LAS float* scr) {
    const int nblk = N / 32, items = (K / 64) * nblk;
    int first = gw - (base % NGW); if (first < 0) first += NGW;
    for (int it = first; it < items; it += NGW) {
        const int kb = it / nblk, nb = it % nblk, n0 = 32 * nb;
        const int d0 = (MAP == 0) ? map_ident(n0) : (MAP == 1) ? map_heads(n0) : map_up(n0);
        p0_transpose_item<FP8>(W, K, N, WT, gain, scr, 64 * kb, n0, d0, F.lane);
    }
    base += items;
}

__device__ __forceinline__ void p0_late_weights(const Frame& F, const Args& a, int gw, int NGW) {
    unsigned char* ws = a.ws;
    LAS float* scr = (LAS float*)(F.lds + F.wave * 16384);
    int base = 0;
    p0_matrix<0>(F, a.in[5], DM, DM, (f16_t*)(ws + WS_WOUTA), nullptr, base, gw, NGW, scr);
    p0_matrix<2>(F, a.in[17], DM, FF2, (f16_t*)(ws + WS_WUP0), a.in[3], base, gw, NGW, scr);
    p0_matrix<0>(F, a.in[20], FF, DM, (f16_t*)(ws + WS_WDN0), nullptr, base, gw, NGW, scr);
}
__device__ __forceinline__ void p0_prologue(const Frame& F, const Args& a) {
    unsigned char* ws = a.ws;
    LAS float* scr = (LAS float*)(F.lds + F.wave * 16384);
    const int gw = F.vcu * NWAVES + F.wave, NGW = F.G * NWAVES;
    int base = 0;
    p0_matrix<0>(F, a.in[4], DM, NA, (f16_t*)(ws + WS_WINA), a.in[2], base, gw, NGW, scr);
    p0_matrix<1, true>(F, a.in[9], DM, NB, (f16_t*)(ws + WS_WINB), a.in[2] + DM, base, gw, NGW, scr);
    p0_matrix<0, true>(F, a.in[10], DM, DM, (f16_t*)(ws + WS_WOUTB), nullptr, base, gw, NGW, scr);
    p0_matrix<2>(F, a.in[17] + (size_t)DM * FF2, DM, FF2, (f16_t*)(ws + WS_WUP1), a.in[3] + DM, base, gw, NGW, scr);
    p0_matrix<0>(F, a.in[20] + (size_t)FF * DM, FF, DM, (f16_t*)(ws + WS_WDN1), nullptr, base, gw, NGW, scr);
    p0_matrix<1>(F, a.in[14], DM, 2 * MEMW, (f16_t*)(ws + WS_WKV), a.in[13], base, gw, NGW, scr);
    for (int ci = F.vcu * 512 + F.tid; ci < NGRP * CHUNK * 16; ci += F.G * 512) { const int g = ci / (CHUNK * 16), t = (ci >> 4) & (CHUNK - 1), c = ci & 15;
        const float* src = a.in[7] + (size_t)g * CHUNK * CHUNK + t * CHUNK + 8 * c; u32x4 o = {0u, 0u, 0u, 0u};
        if (8 * c <= t) { const f32x4 x0 = *(const f32x4*)src, x1 = *(const f32x4*)(src + 4); float v[8] = {x0[0], x0[1], x0[2], x0[3], x1[0], x1[1], x1[2], x1[3]};
#pragma unroll
            for (int j = 0; j < 8; ++j) v[j] = (8 * c + j <= t) ? v[j] : 0.f;
            o.x = pkh(v[0], v[1]); o.y = pkh(v[2], v[3]); o.z = pkh(v[4], v[5]); o.w = pkh(v[6], v[7]); }
        *(u32x4*)(ws + WS_W16S + (size_t)g * 32768 + t * 256 + ((c ^ (t & 15)) << 4)) = o; }
    {
        const float* x = a.in[0]; f16_t* A16 = (f16_t*)(ws + WS_A16); float* ss0 = (float*)(F.ctl + CW_SS0);
        for (int m0 = gw; m0 < M; m0 += 4 * NGW) {
            f32x4 v[4][4];
#pragma unroll
            for (int r = 0; r < 4; ++r) { const int mm = (m0 + r * NGW < M) ? m0 + r * NGW : m0; const GAS f32x4* xr = (const GAS f32x4*)(x + (size_t)mm * DM) + F.lane;
#pragma unroll
                for (int j = 0; j < 4; ++j) v[r][j] = __builtin_nontemporal_load(xr + 64 * j); }
#pragma unroll
            for (int r = 0; r < 4; ++r) { const int m = m0 + r * NGW; if (m >= M) break; float s = 0.f;
#pragma unroll
                for (int j = 0; j < 4; ++j) s += (v[r][j].x * v[r][j].x + v[r][j].y * v[r][j].y) + (v[r][j].z * v[r][j].z + v[r][j].w * v[r][j].w);
                s = wave_sum(s);
                if (F.lane == 0) ss0[m] = s;
                GAS u32x2* o8 = (GAS u32x2*)(A16 + (size_t)m * DM) + F.lane;
#pragma unroll
                for (int j = 0; j < 4; ++j) { u32x2 w; w.x = pkh(v[r][j].x, v[r][j].y); w.y = pkh(v[r][j].z, v[r][j].w); o8[64 * j] = w; } }
        }
    }
    {
        const float* x = a.in[1]; f16_t* X16 = (f16_t*)(ws + WS_MEM16); float* ssm = (float*)(F.ctl + CW_SSM);
        for (int m = gw; m < BATCH * NMEM; m += NGW) {
            const GAS f32x4* xr = (const GAS f32x4*)(x + (size_t)m * DM) + F.lane;
            f32x4 v[4]; float s = 0.f;
#pragma unroll
            for (int j = 0; j < 4; ++j) { v[j] = xr[64 * j]; s += (v[j].x * v[j].x + v[j].y * v[j].y) + (v[j].z * v[j].z + v[j].w * v[j].w); }
            s = wave_sum(s);
            if (F.lane == 0) ssm[m] = s;
            GAS u32x2* o8 = (GAS u32x2*)(X16 + (size_t)m * DM) + F.lane;
#pragma unroll
            for (int j = 0; j < 4; ++j) { u32x2 w; w.x = pkh(v[j].x, v[j].y); w.y = pkh(v[j].z, v[j].w); o8[64 * j] = w; }
        }
    }
}

typedef short v4i16_t __attribute__((ext_vector_type(4)));
__device__ __forceinline__ h16x4 vtr(LAS const unsigned char* p) { return __builtin_bit_cast(h16x4, __builtin_amdgcn_ds_read_tr16_b64_v4i16((LAS v4i16_t*)p)); }
__device__ __forceinline__ h16x8 cat8(h16x4 lo, h16x4 hi) { return (h16x8){lo[0], lo[1], lo[2], lo[3], hi[0], hi[1], hi[2], hi[3]}; }
__device__ __forceinline__ u32x4 pair16(u32x2 a, u32x2 b) {
    const auto r0 = __builtin_amdgcn_permlane16_swap(a.x, b.x, false, false), r1 = __builtin_amdgcn_permlane16_swap(a.y, b.y, false, false);
    return (u32x4){r0[0], r1[0], r0[1], r1[1]};
}
__device__ __forceinline__ void unpair16(u32x4 v, u32x2& a, u32x2& b) {
    const auto r0 = __builtin_amdgcn_permlane16_swap(v.x, v.z, false, false), r1 = __builtin_amdgcn_permlane16_swap(v.y, v.w, false, false);
    a = (u32x2){r0[0], r1[0]}; b = (u32x2){r0[1], r1[1]};
}
__device__ __forceinline__ int pair16_dim(int G, int dt0) { return (G & 1) ? 16 * (dt0 + 1) + 4 * (G - 1) : 16 * dt0 + 4 * G; }
__device__ __forceinline__ void store_o16(f16_t* rowp, const f32x4 (&o)[4], float il, int G) {
#pragma unroll
    for (int pr = 0; pr < 2; ++pr) { const int dt0 = 2 * pr;
        u32x2 a, b; a.x = pkh(o[dt0][0] * il, o[dt0][1] * il); a.y = pkh(o[dt0][2] * il, o[dt0][3] * il); b.x = pkh(o[dt0 + 1][0] * il, o[dt0 + 1][1] * il); b.y = pkh(o[dt0 + 1][2] * il, o[dt0 + 1][3] * il);
        *(u32x4*)(rowp + pair16_dim(G, dt0)) = pair16(a, b); }
}
__device__ __forceinline__ void store_o8(unsigned char* rowp, const f32x4 (&o)[4], float il, int G) {
    const float c = il * F8_SY;
#pragma unroll
    for (int pr = 0; pr < 2; ++pr) { const int dt0 = 2 * pr;
        const unsigned a = pk8(o[dt0][0] * c, o[dt0][1] * c, o[dt0][2] * c, o[dt0][3] * c), b = pk8(o[dt0 + 1][0] * c, o[dt0 + 1][1] * c, o[dt0 + 1][2] * c, o[dt0 + 1][3] * c);
        const auto r = __builtin_amdgcn_permlane16_swap(a, b, false, false);
        *(u32x2*)(rowp + pair16_dim(G, dt0)) = (u32x2){r[0], r[1]}; }
}
constexpr float LOG2E = 1.4426950408889634f;
constexpr float BOUND_SHIFT = 4.0f;

__device__ __forceinline__ void stage_k_img(LAS unsigned char* img, const f16_t* src, int pitch, int nrows, int tid) {
    for (int ci = tid; ci < nrows * 8; ci += 512) { const int r = ci >> 3, c = ci & 7;
        const u32x4 v = *(const u32x4*)(src + (size_t)r * pitch + 8 * c);
        *(LAS u32x4*)(img + r * 128 + ((c ^ (r & 7)) << 4)) = v; }
}
__device__ __forceinline__ void stage_v_img(LAS unsigned char* img, const f16_t* src, int pitch, int nrows, int tid) {
    for (int ci = tid; ci < nrows * 8; ci += 512) { const int r = ci >> 3, c = ci & 7;
        const u32x4 v = *(const u32x4*)(src + (size_t)r * pitch + 8 * c);
        *(LAS u32x4*)(img + r * 128 + ((((c >> 1) ^ ((r >> 1) & 3))) << 5) + ((c & 1) << 4)) = v; }
}
__device__ __forceinline__ void glds16_asm(const void* gsrc, unsigned lds_dst) { unsigned keep;
    asm volatile("s_mov_b32 %0, m0\n\ts_mov_b32 m0, %2\n\ts_nop 0\n\tglobal_load_lds_dwordx4 %1, off\n\ts_mov_b32 m0, %0" : "=&s"(keep) : "v"(gsrc), "s"(lds_dst) : "memory"); }
__device__ __forceinline__ void dma_kv_imgs(LAS unsigned char* Kimg, LAS unsigned char* Vimg, const f16_t* ksrc, const f16_t* vsrc, int wave, int lane, int pitch = NB) {
    const int rl = lane >> 3, pos = lane & 7;
    const int kc = pos ^ rl, vc = 2 * ((pos >> 1) ^ ((lane >> 4) & 3)) + (pos & 1);
    const unsigned kd = (unsigned)__builtin_amdgcn_readfirstlane((int)(unsigned)(uintptr_t)Kimg), vd = (unsigned)__builtin_amdgcn_readfirstlane((int)(unsigned)(uintptr_t)Vimg);
#pragma unroll
    for (int i = 0; i < 4; ++i) { const int pc = wave + 8 * i, row = 8 * pc + rl;
        glds16_asm(ksrc + (size_t)row * pitch + 8 * kc, (unsigned)__builtin_amdgcn_readfirstlane((int)(kd + pc * 1024)));
        glds16_asm(vsrc + (size_t)row * pitch + 8 * vc, (unsigned)__builtin_amdgcn_readfirstlane((int)(vd + pc * 1024))); }
}
template <bool CAUSAL>
__device__ __forceinline__ void attn_tile(LAS const unsigned char* Kimg, LAS const unsigned char* Vimg, int nsteps, h16x8 q0, h16x8 q1, float mb, int qrel, f32x4 (&o)[4], float& lsum, int lane) {
    const int fr = lane & 15, G = lane >> 4, qq = fr >> 2, p = fr & 3;
    const int kof0 = fr * 128 + (((0 + G) ^ (fr & 7)) << 4), kof1 = fr * 128 + (((4 + G) ^ (fr & 7)) << 4);
    const int vrow = (4 * G + qq) * 128 + p * 8, sw = (2 * G + (qq >> 1)) & 3;
    for (int ks = 0; ks < nsteps; ++ks) {
        LAS const unsigned char* kb = Kimg + ks * 4096;
        const h16x8 a00 = *(LAS const h16x8*)(kb + kof0), a01 = *(LAS const h16x8*)(kb + kof1);
        const h16x8 a10 = *(LAS const h16x8*)(kb + 2048 + kof0), a11 = *(LAS const h16x8*)(kb + 2048 + kof1);
        f32x4 s0 = {0.f, 0.f, 0.f, 0.f}, s1 = {0.f, 0.f, 0.f, 0.f};
        s0 = __builtin_amdgcn_mfma_f32_16x16x32_f16(a00, q0, s0, 0, 0, 0); s0 = __builtin_amdgcn_mfma_f32_16x16x32_f16(a01, q1, s0, 0, 0, 0);
        s1 = __builtin_amdgcn_mfma_f32_16x16x32_f16(a10, q0, s1, 0, 0, 0); s1 = __builtin_amdgcn_mfma_f32_16x16x32_f16(a11, q1, s1, 0, 0, 0);
        f32x4 p0, p1;
#pragma unroll
        for (int e = 0; e < 4; ++e) { p0[e] = __builtin_amdgcn_exp2f(s0[e] - mb); p1[e] = __builtin_amdgcn_exp2f(s1[e] - mb); }
        if (CAUSAL) { const int kr = ks * 32 + 4 * G;
#pragma unroll
            for (int e = 0; e < 4; ++e) { if (kr + e > qrel) p0[e] = 0.f; if (kr + 16 + e > qrel) p1[e] = 0.f; } }
        lsum += ((p0[0] + p0[1]) + (p0[2] + p0[3])) + ((p1[0] + p1[1]) + (p1[2] + p1[3]));
        u32x4 pw; pw.x = pkh(p0[0], p0[1]); pw.y = pkh(p0[2], p0[3]); pw.z = pkh(p1[0], p1[1]); pw.w = pkh(p1[2], p1[3]);
        const h16x8 pf = __builtin_bit_cast(h16x8, pw);
        LAS const unsigned char* vb = Vimg + ks * 4096 + vrow;
#pragma unroll
        for (int dt = 0; dt < 4; ++dt) {
            const h16x4 lo = vtr(vb + ((dt ^ sw) << 5)), hi = vtr(vb + 2048 + ((dt ^ sw) << 5));
            o[dt] = __builtin_amdgcn_mfma_f32_16x16x32_f16(cat8(lo, hi), pf, o[dt], 0, 0, 0);
        }
    }
}
template <bool CAUSAL, bool SHARED>
__device__ __forceinline__ void attn_tile2(LAS const unsigned char* Ka, LAS const unsigned char* Va, LAS const unsigned char* Kb, LAS const unsigned char* Vb, int nsteps,
                                           h16x8 qa0, h16x8 qa1, float mba, int qrela, h16x8 qb0, h16x8 qb1, float mbb, int qrelb,
                                           f32x4 (&oa)[4], f32x4 (&ob)[4], float& lsa_out, float& lsb_out, int lane) {
    const int fr = lane & 15, G = lane >> 4, qq = fr >> 2, p = fr & 3;
    const int kof0 = fr * 128 + (((0 + G) ^ (fr & 7)) << 4), kof1 = fr * 128 + (((4 + G) ^ (fr & 7)) << 4);
    const int vrow = (4 * G + qq) * 128 + p * 8, sw = (2 * G + (qq >> 1)) & 3;
    const h16x8 ones = {(_Float16)1.0f, (_Float16)1.0f, (_Float16)1.0f, (_Float16)1.0f, (_Float16)1.0f, (_Float16)1.0f, (_Float16)1.0f, (_Float16)1.0f};
    const f32x4 nma = {-mba, -mba, -mba, -mba}, nmb = {-mbb, -mbb, -mbb, -mbb};
    f32x4 la = {0.f, 0.f, 0.f, 0.f}, lb = la;
    h16x8 ka[4], kb[4];
    ka[0] = *(LAS const h16x8*)(Ka + kof0); ka[1] = *(LAS const h16x8*)(Ka + kof1); ka[2] = *(LAS const h16x8*)(Ka + 2048 + kof0); ka[3] = *(LAS const h16x8*)(Ka + 2048 + kof1);
    if (!SHARED) { kb[0] = *(LAS const h16x8*)(Kb + kof0); kb[1] = *(LAS const h16x8*)(Kb + kof1); kb[2] = *(LAS const h16x8*)(Kb + 2048 + kof0); kb[3] = *(LAS const h16x8*)(Kb + 2048 + kof1); }
    for (int ks = 0; ks < nsteps; ++ks) {
        LAS const unsigned char* va = Va + ks * 4096 + vrow; LAS const unsigned char* vb = Vb + ks * 4096 + vrow;
        h16x4 fal[4], fah[4], fbl[4], fbh[4];
#pragma unroll
        for (int dt = 0; dt < 4; ++dt) { fal[dt] = vtr(va + ((dt ^ sw) << 5)); fah[dt] = vtr(va + 2048 + ((dt ^ sw) << 5));
            if (!SHARED) { fbl[dt] = vtr(vb + ((dt ^ sw) << 5)); fbh[dt] = vtr(vb + 2048 + ((dt ^ sw) << 5)); } }
        __builtin_amdgcn_sched_barrier(0);
        f32x4 sa0, sa1, sb0, sb1;
        sa0 = __builtin_amdgcn_mfma_f32_16x16x32_f16(ka[0], qa0, nma, 0, 0, 0); sb0 = __builtin_amdgcn_mfma_f32_16x16x32_f16(SHARED ? ka[0] : kb[0], qb0, nmb, 0, 0, 0);
        sa1 = __builtin_amdgcn_mfma_f32_16x16x32_f16(ka[2], qa0, nma, 0, 0, 0); sb1 = __builtin_amdgcn_mfma_f32_16x16x32_f16(SHARED ? ka[2] : kb[2], qb0, nmb, 0, 0, 0);
        sa0 = __builtin_amdgcn_mfma_f32_16x16x32_f16(ka[1], qa1, sa0, 0, 0, 0); sb0 = __builtin_amdgcn_mfma_f32_16x16x32_f16(SHARED ? ka[1] : kb[1], qb1, sb0, 0, 0, 0);
        sa1 = __builtin_amdgcn_mfma_f32_16x16x32_f16(ka[3], qa1, sa1, 0, 0, 0); sb1 = __builtin_amdgcn_mfma_f32_16x16x32_f16(SHARED ? ka[3] : kb[3], qb1, sb1, 0, 0, 0);
        __builtin_amdgcn_sched_barrier(0);
        if (ks + 1 < nsteps) { LAS const unsigned char* kn = Ka + (ks + 1) * 4096;
            ka[0] = *(LAS const h16x8*)(kn + kof0); ka[1] = *(LAS const h16x8*)(kn + kof1); ka[2] = *(LAS const h16x8*)(kn + 2048 + kof0); ka[3] = *(LAS const h16x8*)(kn + 2048 + kof1);
            if (!SHARED) { LAS const unsigned char* kn2 = Kb + (ks + 1) * 4096;
                kb[0] = *(LAS const h16x8*)(kn2 + kof0); kb[1] = *(LAS const h16x8*)(kn2 + kof1); kb[2] = *(LAS const h16x8*)(kn2 + 2048 + kof0); kb[3] = *(LAS const h16x8*)(kn2 + 2048 + kof1); } }
        __builtin_amdgcn_sched_barrier(0);
        f32x4 pa0, pa1, pb0, pb1;
#pragma unroll
        for (int e = 0; e < 4; ++e) { pa0[e] = __builtin_amdgcn_exp2f(sa0[e]); pa1[e] = __builtin_amdgcn_exp2f(sa1[e]);
                                      pb0[e] = __builtin_amdgcn_exp2f(sb0[e]); pb1[e] = __builtin_amdgcn_exp2f(sb1[e]); }
        if (CAUSAL) { const int kr = ks * 32 + 4 * G;
#pragma unroll
            for (int e = 0; e < 4; ++e) { if (kr + e > qrela) pa0[e] = 0.f; if (kr + 16 + e > qrela) pa1[e] = 0.f; if (kr + e > qrelb) pb0[e] = 0.f; if (kr + 16 + e > qrelb) pb1[e] = 0.f; } }
        u32x4 wa, wb; wa.x = pkh(pa0[0], pa0[1]); wa.y = pkh(pa0[2], pa0[3]); wa.z = pkh(pa1[0], pa1[1]); wa.w = pkh(pa1[2], pa1[3]);
        wb.x = pkh(pb0[0], pb0[1]); wb.y = pkh(pb0[2], pb0[3]); wb.z = pkh(pb1[0], pb1[1]); wb.w = pkh(pb1[2], pb1[3]);
        const h16x8 pfa = __builtin_bit_cast(h16x8, wa), pfb = __builtin_bit_cast(h16x8, wb);
        la = __builtin_amdgcn_mfma_f32_16x16x32_f16(ones, pfa, la, 0, 0, 0); lb = __builtin_amdgcn_mfma_f32_16x16x32_f16(ones, pfb, lb, 0, 0, 0);
#pragma unroll
        for (int dt = 0; dt < 4; ++dt) {
            const h16x8 fa = cat8(fal[dt], fah[dt]);
            const h16x8 fb = SHARED ? fa : cat8(fbl[dt], fbh[dt]);
            oa[dt] = __builtin_amdgcn_mfma_f32_16x16x32_f16(fa, pfa, oa[dt], 0, 0, 0);
            ob[dt] = __builtin_amdgcn_mfma_f32_16x16x32_f16(fb, pfb, ob[dt], 0, 0, 0);
        }
    }
    lsa_out = la[0]; lsb_out = lb[0];
}
__device__ __forceinline__ float wave_max(float v) {
#pragma unroll
    for (int o = 1; o < 64; o <<= 1) v = fmaxf(v, __shfl_xor(v, o));
    return v;
}
__device__ __forceinline__ void xattn_load_q(const f16_t* qp  , const float* gqm, int G, float maxgk, h16x8& q0, h16x8& q1, float& mb) {
    const h16x8 r0v = *(const h16x8*)qp, r1v = *(const h16x8*)(qp + 32);
    float q[16], ss = 0.f;
#pragma unroll
    for (int j = 0; j < 8; ++j) { q[j] = (float)r0v[j]; q[8 + j] = (float)r1v[j]; ss += q[j] * q[j] + q[8 + j] * q[8 + j]; }
    ss += __shfl_xor(ss, 16); ss += __shfl_xor(ss, 32);
    const float rn = 1.0f / sqrtf(ss * (1.0f / HD) + EPS);
    float n2 = 0.f;
#pragma unroll
    for (int j = 0; j < 8; ++j) { q[j] *= rn * gqm[8 * G + j]; q[8 + j] *= rn * gqm[32 + 8 * G + j]; n2 += q[j] * q[j] + q[8 + j] * q[8 + j]; }
    n2 += __shfl_xor(n2, 16); n2 += __shfl_xor(n2, 32);
    mb = (sqrtf(n2) * maxgk - BOUND_SHIFT) * LOG2E;
    const float c = 0.125f * LOG2E;
    u32x4 w0, w1;
    w0.x = pkh(q[0] * c, q[1] * c); w0.y = pkh(q[2] * c, q[3] * c); w0.z = pkh(q[4] * c, q[5] * c); w0.w = pkh(q[6] * c, q[7] * c);
    w1.x = pkh(q[8] * c, q[9] * c); w1.y = pkh(q[10] * c, q[11] * c); w1.z = pkh(q[12] * c, q[13] * c); w1.w = pkh(q[14] * c, q[15] * c);
    q0 = __builtin_bit_cast(h16x8, w0); q1 = __builtin_bit_cast(h16x8, w1);
}
template <bool Y8>
__device__ __forceinline__ void xattn_chunk(const Frame& F, const Args& a, int chunk, const f16_t* P, int ldp, int qcol0, const float* gqm, f16_t* Y) {
    const float* gkm = a.in[15];
    const f16_t* KM = (const f16_t*)(a.ws + WS_KM16); const f16_t* VM = (const f16_t*)(a.ws + WS_VM16);
    const int r0 = chunk * CHUNK, b = r0 / SEQ, lane = F.lane, fr = lane & 15, G = lane >> 4;
    const float maxgk = wave_max(fabsf(gkm[lane]));
    const int hsel = F.wave >> 2, rowa = r0 + 32 * (F.wave & 3) + fr, rowb = rowa + 16;
    for (int hp = 0; hp < 2; ++hp) {
#pragma unroll
        for (int k = 0; k < 2; ++k) dma_kv_imgs(F.lds + k * 65536, F.lds + k * 65536 + 32768, KM + (size_t)(b * 4 + 2 * hp + k) * NMEM * HD, VM + (size_t)(b * 4 + 2 * hp + k) * NMEM * HD, F.wave, lane, HD);
        const int head = 2 * hp + hsel;
        h16x8 qa0, qa1, qb0, qb1; float mba, mbb;
        xattn_load_q(P + (size_t)rowa * ldp + qcol0 + head * HD + 8 * G, gqm, G, maxgk, qa0, qa1, mba);
        xattn_load_q(P + (size_t)rowb * ldp + qcol0 + head * HD + 8 * G, gqm, G, maxgk, qb0, qb1, mbb);
        VM_WAIT();
        __syncthreads();
        f32x4 oa[4], ob[4]; float lsa = 0.f, lsb = 0.f;
#pragma unroll
        for (int dt = 0; dt < 4; ++dt) { oa[dt] = (f32x4){0.f, 0.f, 0.f, 0.f}; ob[dt] = oa[dt]; }
        LAS const unsigned char* img = F.lds + hsel * 65536;
        attn_tile2<false, true>(img, img + 32768, img, img + 32768, NMEM / 32, qa0, qa1, mba, 0, qb0, qb1, mbb, 0, oa, ob, lsa, lsb, lane);
        const float ila = 1.0f / lsa, ilb = 1.0f / lsb;
        if constexpr (Y8) { unsigned char* yp = (unsigned char*)Y + MIXW + head * HD; store_o8(yp + (size_t)rowa * DM, oa, ila, G); store_o8(yp + (size_t)rowb * DM, ob, ilb, G); }
        else { f16_t* yp = Y + MIXW + head * HD; store_o16(yp + (size_t)rowa * DM, oa, ila, G); store_o16(yp + (size_t)rowb * DM, ob, ilb, G); }
        __syncthreads();
    }
}

template <bool DO_SGU, bool DO_X>
__device__ __forceinline__ void mixer_a(const Frame& F, const Args& a) {
    const f16_t* P = (const f16_t*)(a.ws + WS_P16); f16_t* Y = (f16_t*)(a.ws + WS_Y16);
    const float* ssv = (const float*)(F.ctl + CW_SSV); const float* gsgu = a.in[6]; const float* wsp = a.in[7]; const float* bsp = a.in[8];
    LAS float* rv = (LAS float*)(F.lds + XCH_OFF);
    const int lane = F.lane, fr = lane & 15, G = lane >> 4, qq = fr >> 2, p = fr & 3, w = F.wave;
    for (int chunk = F.vcu; chunk < M / CHUNK; chunk += F.G) {
        const int r0 = chunk * CHUNK;
        if (F.tid < CHUNK) rv[F.tid] = 1.0f / sqrtf(ssv[r0 + F.tid] * (1.0f / MIXW) + EPS);
        __syncthreads();
        h16x8 zvr[4];
        if (DO_SGU) {
#pragma unroll
            for (int k4 = 0; k4 < 4; ++k4) { const int ci = F.tid + 512 * k4, s2 = ci >> 4, c = ci & 15; zvr[k4] = __builtin_nontemporal_load((const h16x8*)(P + (size_t)(r0 + s2) * NA + MIXW + 8 * c)); } }
        for (int g = 0; g < (DO_SGU ? NGRP : 0); ++g) {
            LAS unsigned char* Wimg = F.lds + (g & 1) * 65536; LAS unsigned char* Vimg = Wimg + 32768;
            { const int c = F.tid & 15; const f32x4 g0 = *(const f32x4*)(gsgu + g * 128 + 8 * c), g1 = *(const f32x4*)(gsgu + g * 128 + 8 * c + 4);
#pragma unroll
              for (int k4 = 0; k4 < 4; ++k4) { const int s2 = (F.tid + 512 * k4) >> 4; const h16x8 zv = zvr[k4]; const float rs = rv[s2];
                u32x4 o; o.x = pkh((float)zv[0] * rs * g0[0], (float)zv[1] * rs * g0[1]); o.y = pkh((float)zv[2] * rs * g0[2], (float)zv[3] * rs * g0[3]);
                o.z = pkh((float)zv[4] * rs * g1[0], (float)zv[5] * rs * g1[1]); o.w = pkh((float)zv[6] * rs * g1[2], (float)zv[7] * rs * g1[3]);
                *(LAS u32x4*)(Vimg + s2 * 256 + (((c >> 1) ^ (s2 & 7)) << 5) + ((c & 1) << 4)) = o; } }
            { const unsigned wd = (unsigned)__builtin_amdgcn_readfirstlane((int)(unsigned)(uintptr_t)Wimg);
#pragma unroll
              for (int i = 0; i < 4; ++i) { const int pc = w + 8 * i; glds16_asm(a.ws + WS_W16S + (size_t)g * 32768 + pc * 1024 + lane * 16, (unsigned)__builtin_amdgcn_readfirstlane((int)(wd + pc * 1024))); } }
            const int t = 16 * w + fr, row = r0 + t;
            h16x8 ur[4];
#pragma unroll
            for (int pr = 0; pr < 4; ++pr) ur[pr] = __builtin_nontemporal_load((const h16x8*)(P + (size_t)row * NA + g * 128 + pair16_dim(G, 2 * pr)));
            if (g + 1 < NGRP) {
#pragma unroll
                for (int k4 = 0; k4 < 4; ++k4) { const int ci = F.tid + 512 * k4, s2 = ci >> 4, c = ci & 15; zvr[k4] = __builtin_nontemporal_load((const h16x8*)(P + (size_t)(r0 + s2) * NA + MIXW + (g + 1) * 128 + 8 * c)); }
                asm volatile("s_waitcnt vmcnt(8)" ::: "memory");
            } else asm volatile("s_waitcnt vmcnt(4)" ::: "memory");
            __syncthreads();
            f32x4 acc[8];
#pragma unroll
            for (int dt = 0; dt < 8; ++dt) acc[dt] = (f32x4){0.f, 0.f, 0.f, 0.f};
            const int nsteps = (w >> 1) + 1;
            for (int ks = 0; ks < nsteps; ++ks) {
                const h16x8 bf = *(LAS const h16x8*)(Wimg + (16 * w + fr) * 256 + (((4 * ks + G) ^ fr) << 4));
                LAS const unsigned char* v0 = Vimg + (32 * ks + 8 * G + qq) * 256 + p * 8;
#pragma unroll
                for (int dt = 0; dt < 8; ++dt) {
                    const h16x4 lo = vtr(v0 + ((dt ^ qq) << 5)), hi = vtr(v0 + 4 * 256 + ((dt ^ (4 + qq)) << 5));
                    acc[dt] = __builtin_amdgcn_mfma_f32_16x16x32_f16(cat8(lo, hi), bf, acc[dt], 0, 0, 0);
                }
            }
            const float bias = bsp[g * CHUNK + t];
#pragma unroll
            for (int pr = 0; pr < 4; ++pr) { const int dt0 = 2 * pr, col = g * 128 + pair16_dim(G, dt0);
                u32x2 xa, xb; xa.x = pkh(acc[dt0][0] + bias, acc[dt0][1] + bias); xa.y = pkh(acc[dt0][2] + bias, acc[dt0][3] + bias);
                xb.x = pkh(acc[dt0 + 1][0] + bias, acc[dt0 + 1][1] + bias); xb.y = pkh(acc[dt0 + 1][2] + bias, acc[dt0 + 1][3] + bias);
                const h16x8 m8 = __builtin_bit_cast(h16x8, pair16(xa, xb));
                *(h16x8*)(Y + (size_t)row * DM + col) = ur[pr] * m8; }
        }
        __syncthreads();
        if (DO_X) xattn_chunk<false>(F, a, chunk, P, NA, 2 * MIXW, a.in[16], Y);
    }
}

__device__ __forceinline__ void moba_load_q(const f16_t* qrow, int G, float maxgk, h16x8& q0, h16x8& q1, float& mb) {
    const h16x8 r0v = *(const h16x8*)(qrow + 8 * G), r1v = *(const h16x8*)(qrow + 32 + 8 * G);
    float q[16], n2 = 0.f;
#pragma unroll
    for (int j = 0; j < 8; ++j) { q[j] = (float)r0v[j]; q[8 + j] = (float)r1v[j]; n2 += q[j] * q[j] + q[8 + j] * q[8 + j]; }
    n2 += __shfl_xor(n2, 16); n2 += __shfl_xor(n2, 32);
    mb = (sqrtf(n2) * maxgk - BOUND_SHIFT) * LOG2E;
    const float c = 0.125f * LOG2E;
    u32x4 w0, w1;
    w0.x = pkh(q[0] * c, q[1] * c); w0.y = pkh(q[2] * c, q[3] * c); w0.z = pkh(q[4] * c, q[5] * c); w0.w = pkh(q[6] * c, q[7] * c);
    w1.x = pkh(q[8] * c, q[9] * c); w1.y = pkh(q[10] * c, q[11] * c); w1.z = pkh(q[12] * c, q[13] * c); w1.w = pkh(q[14] * c, q[15] * c);
    q0 = __builtin_bit_cast(h16x8, w0); q1 = __builtin_bit_cast(h16x8, w1);
}
__device__ __forceinline__ void moba_finish_q(h16x8 r0v, h16x8 r1v, float maxgk, h16x8& q0, h16x8& q1, float& mb) {
    float q[16], n2 = 0.f;
#pragma unroll
    for (int j = 0; j < 8; ++j) { q[j] = (float)r0v[j]; q[8 + j] = (float)r1v[j]; n2 += q[j] * q[j] + q[8 + j] * q[8 + j]; }
    n2 += __shfl_xor(n2, 16); n2 += __shfl_xor(n2, 32);
    mb = (sqrtf(n2) * maxgk - BOUND_SHIFT) * LOG2E;
    const float c = 0.125f * LOG2E;
    u32x4 w0, w1;
    w0.x = pkh(q[0] * c, q[1] * c); w0.y = pkh(q[2] * c, q[3] * c); w0.z = pkh(q[4] * c, q[5] * c); w0.w = pkh(q[6] * c, q[7] * c);
    w1.x = pkh(q[8] * c, q[9] * c); w1.y = pkh(q[10] * c, q[11] * c); w1.z = pkh(q[12] * c, q[13] * c); w1.w = pkh(q[14] * c, q[15] * c);
    q0 = __builtin_bit_cast(h16x8, w0); q1 = __builtin_bit_cast(h16x8, w1);
}
constexpr int LIST_CAP = 768, OFFS_LD = 68;

__device__ __forceinline__ unsigned sel_key(float g, int j) {
    const unsigned b = __builtin_bit_cast(unsigned, g);
    const unsigned o = (b & 0x80000000u) ? ~b : (b | 0x80000000u);
    return (o & ~63u) | (unsigned)(63 - j);
}
#define SEL_INSERT(k) do { const unsigned a_ = min(t0, (k)); t0 = max(t0, (k)); const unsigned b_ = min(t1, a_); t1 = max(t1, a_); t2 = max(t2, b_); } while (0)
__device__ __forceinline__ void moba_select(const Frame& F, const Args& a) {
    const f16_t* P = (const f16_t*)(a.ws + WS_P16);
    const float* kmean = (const float*)(F.ctl + CW_KMEAN);
    unsigned short* LIST = (unsigned short*)(a.ws + WS_LIST); unsigned short* OFFS = (unsigned short*)(a.ws + WS_OFFS);
    LAS unsigned char* KMhi = F.lds; LAS unsigned char* KMlo = F.lds + 8192;
    LAS int* cnt = (LAS int*)(F.lds + 16384);
    LAS int* off = cnt + 64;
    LAS int* cur = off + 72;
    LAS unsigned short* sorted = (LAS unsigned short*)(F.lds + 17408);
    const int lane = F.lane, fr = lane & 15, G = lane >> 4, w = F.wave, tid = F.tid;
    for (int unit = F.vcu; unit < BATCH * NBLK * MOBA_H; unit += F.G) {
        const int h = unit % MOBA_H, qb = (unit / MOBA_H) % NBLK, b = unit / (MOBA_H * NBLK);
        const size_t ub = (size_t)(b * MOBA_H + h) * NBLK + qb;
        __syncthreads();
        if (tid < 64) { cnt[tid] = 0; cur[tid] = 0; }
        { const int j = tid >> 3, c = tid & 7; const float* src = kmean + ((size_t)(b * MOBA_H + h) * NBLK + j) * HD + 8 * c;
          const f32x4 x0 = *(const f32x4*)src, x1 = *(const f32x4*)(src + 4);
          const float v[8] = {x0[0], x0[1], x0[2], x0[3], x1[0], x1[1], x1[2], x1[3]}; float hi[8], lo[8];
#pragma unroll
          for (int e = 0; e < 8; ++e) { hi[e] = (float)(_Float16)v[e]; lo[e] = v[e] - hi[e]; }
          u32x4 wh, wl; wh.x = pkh(hi[0], hi[1]); wh.y = pkh(hi[2], hi[3]); wh.z = pkh(hi[4], hi[5]); wh.w = pkh(hi[6], hi[7]);
          wl.x = pkh(lo[0], lo[1]); wl.y = pkh(lo[2], lo[3]); wl.z = pkh(lo[4], lo[5]); wl.w = pkh(lo[6], lo[7]);
          *(LAS u32x4*)(KMhi + j * 128 + ((c ^ (j & 7)) << 4)) = wh; *(LAS u32x4*)(KMlo + j * 128 + ((c ^ (j & 7)) << 4)) = wl; }
        __syncthreads();
        const int nsel = qb < 3 ? qb : 3, njt = qb > 0 ? ((qb - 1) >> 4) + 1 : 0;
        int isel[2] = {0, 0};
#pragma unroll
        for (int rep = 0; rep < 2; ++rep) {
            const int qi = 16 * (w + 8 * rep) + fr;
            const f16_t* qp = P + (size_t)(b * SEQ + qb * MOBA_BLK + qi) * NB + h * HD + 8 * G;
            const h16x8 q0 = *(const h16x8*)qp, q1 = *(const h16x8*)(qp + 32);
            unsigned t0 = 0u, t1 = 0u, t2 = 0u;
            const int kof0 = fr * 128 + (((0 + G) ^ (fr & 7)) << 4), kof1 = fr * 128 + (((4 + G) ^ (fr & 7)) << 4);
            for (int jt = 0; jt < njt; ++jt) {
                f32x4 acc = {0.f, 0.f, 0.f, 0.f};
                acc = __builtin_amdgcn_mfma_f32_16x16x32_f16(*(LAS const h16x8*)(KMhi + jt * 2048 + kof0), q0, acc, 0, 0, 0);
                acc = __builtin_amdgcn_mfma_f32_16x16x32_f16(*(LAS const h16x8*)(KMhi + jt * 2048 + kof1), q1, acc, 0, 0, 0);
                acc = __builtin_amdgcn_mfma_f32_16x16x32_f16(*(LAS const h16x8*)(KMlo + jt * 2048 + kof0), q0, acc, 0, 0, 0);
                acc = __builtin_amdgcn_mfma_f32_16x16x32_f16(*(LAS const h16x8*)(KMlo + jt * 2048 + kof1), q1, acc, 0, 0, 0);
#pragma unroll
                for (int e = 0; e < 4; ++e) { const int j = 16 * jt + 4 * G + e; const unsigned k = (j < qb) ? sel_key(acc[e], j) : 0u; SEL_INSERT(k); }
            }
#pragma unroll
            for (int x = 16; x <= 32; x <<= 1) {
                const unsigned p0 = (unsigned)__shfl_xor((int)t0, x), p1 = (unsigned)__shfl_xor((int)t1, x), p2 = (unsigned)__shfl_xor((int)t2, x);
                SEL_INSERT(p0); SEL_INSERT(p1); SEL_INSERT(p2);
            }
            const unsigned tk = (G == 0) ? t0 : (G == 1) ? t1 : t2;
            isel[rep] = 63 - (int)(tk & 63u);
            if (G < nsel) __hip_atomic_fetch_add(cnt + isel[rep], 1, __ATOMIC_RELAXED, __HIP_MEMORY_SCOPE_WORKGROUP);
        }
        __syncthreads();
        if (w == 0) { const int c = cnt[lane]; int s = c;
#pragma unroll
            for (int o = 1; o < 64; o <<= 1) { const int t = __shfl_up(s, o); if (lane >= o) s += t; }
            off[lane] = s - c; if (lane == 63) off[64] = s; }
        __syncthreads();
#pragma unroll
        for (int rep = 0; rep < 2; ++rep) if (G < nsel) {
            const int qi = 16 * (w + 8 * rep) + fr;
            const int pos = __hip_atomic_fetch_add(cur + isel[rep], 1, __ATOMIC_RELAXED, __HIP_MEMORY_SCOPE_WORKGROUP);
            sorted[off[isel[rep]] + pos] = (unsigned short)((qi << 2) | G); }
        __syncthreads();
        const int total = off[64];
        for (int k = tid; k < total; k += 512) LIST[ub * LIST_CAP + k] = sorted[k];
        if (tid < 65) OFFS[ub * OFFS_LD + tid] = (unsigned short)off[tid];
    }
}
#undef SEL_INSERT

constexpr int SP_PART = 512;
struct SpItem { int n, lq, j; unsigned short raw; };
__device__ __forceinline__ void sp_prefetch(int it, int bh, LAS const int* IP, LAS const int* NJ, LAS const unsigned short* cum, LAS const unsigned short* offs, const unsigned short* LIST,
                                            const f16_t* P, LAS unsigned char* img, int wave, int lane, int tid, SpItem& o) {
    int l2 = 0, h2 = 64; while (h2 - l2 > 1) { const int mid = (l2 + h2) >> 1; if (IP[mid] <= it) l2 = mid; else h2 = mid; }
    const int j = l2, part = it - IP[l2], b = bh / MOBA_H, h = bh % MOBA_H;
    int n = NJ[j] - part * SP_PART; if (n > SP_PART) n = SP_PART; o.n = n; o.j = j;
    const f16_t* kb = P + (size_t)(b * SEQ + j * MOBA_BLK) * NB + MIXW + h * HD;
    dma_kv_imgs(img, img + 32768, kb, kb + MIXW, wave, lane);
    const int ei = (lane < 32) ? 32 * wave + lane : 256 + 32 * wave + (lane - 32);
    if (ei < n) { const int e = part * SP_PART + ei; const LAS unsigned short* cj = cum + j; int lq = 0, hq = 64;
        while (hq - lq > 1) { const int mid = (lq + hq) >> 1; if ((int)cj[mid * NBLK] <= e) lq = mid; else hq = mid; }
        o.lq = lq;
        o.raw = LIST[((size_t)bh * NBLK + lq) * LIST_CAP + offs[lq * OFFS_LD + j] + (e - (int)cj[lq * NBLK])]; }
}
template <bool ENGINE, int ESTEPS>
__device__ __forceinline__ void moba_sparse(const Frame& F, const Args& a, int rep) {
    const f16_t* P = (const f16_t*)(a.ws + WS_P16);
    const unsigned short* LIST = (const unsigned short*)(a.ws + WS_LIST); const unsigned short* OFFS = (const unsigned short*)(a.ws + WS_OFFS);
    f16_t* PO = (f16_t*)(a.ws + WS_PO); float* PL = (float*)(a.ws + WS_PL);
    const int ncl = F.G / 8; if (ncl == 0) return;
    const int xg = F.vcu / ncl; if (xg >= 8) return;
    LAS unsigned short* offs = (LAS unsigned short*)(F.lds + 131072);
    LAS unsigned short* cum = (LAS unsigned short*)(F.lds + 139776);
    LAS int* NJ = (LAS int*)(F.lds + 147968);
    LAS int* IP = NJ + 64;
    LAS unsigned* plist = (LAS unsigned*)(F.lds + 148992);
    LAS int* itq = (LAS int*)(F.lds + 151040);
    const int lane = F.lane, fr = lane & 15, G = lane >> 4, w = F.wave, tid = F.tid;
    const float maxgk = wave_max(fabsf(a.in[12][lane]));
    for (int bl = 0; bl < 3; ++bl) {
        const int bh = xg + 8 * bl, b = bh / MOBA_H, h = bh % MOBA_H;
        unsigned* qctr = (unsigned*)(F.ctl + CW_QUEUE + 64 * (xg * 3 + bl) + 2048 * rep);
        __syncthreads();
        { constexpr int NW = NBLK * OFFS_LD / 2, NL = (NW + 511) / 512; unsigned tv[NL]; const unsigned* src = (const unsigned*)(OFFS + (size_t)bh * NBLK * OFFS_LD);
#pragma unroll
          for (int i = 0; i < NL; ++i) { const int ix = tid + 512 * i; tv[i] = src[ix < NW ? ix : 0]; }
#pragma unroll
          for (int i = 0; i < NL; ++i) { const int ix = tid + 512 * i; if (ix < NW) ((LAS unsigned*)offs)[ix] = tv[i]; } }
        if (tid == 0) { itq[0] = (int)__hip_atomic_fetch_add(qctr, 1u, RLX_AGENT); itq[1] = (int)__hip_atomic_fetch_add(qctr, 1u, RLX_AGENT); }
        __syncthreads();
#pragma unroll
        for (int jj = 0; jj < 8; ++jj) { const int j = 8 * w + jj, qb = lane;
            const int c = (qb > j && j < NBLK - 1) ? (int)offs[qb * OFFS_LD + j + 1] - (int)offs[qb * OFFS_LD + j] : 0; int sc = c;
#pragma unroll
            for (int o = 1; o < 64; o <<= 1) { const int t = __shfl_up(sc, o); if (lane >= o) sc += t; }
            cum[qb * NBLK + j] = (unsigned short)(sc - c);
            if (lane == 63) NJ[j] = sc; }
        __syncthreads();
        if (tid < 64) { const int j = tid; const int acc = NJ[j];
            const int c = (acc + SP_PART - 1) / SP_PART; int s = c;
#pragma unroll
            for (int o = 1; o < 64; o <<= 1) { const int t = __shfl_up(s, o); if (lane >= o) s += t; }
            IP[j] = s - c; if (j == 63) IP[64] = s; }
        __syncthreads();
        const int TI = IP[64];
        int it_cur = itq[0], it_nxt = itq[1], cb = 0;
        SpItem pf; pf.n = 0; pf.lq = 0; pf.j = 0; pf.raw = 0;
        if (it_cur < TI) sp_prefetch(it_cur, bh, IP, NJ, cum, offs, LIST, P, F.lds, w, lane, tid, pf);
        for (int iter = 0;; ++iter) {
            VM_WAIT();
            const int coming = (iter == 0) ? it_cur : it_nxt; const bool have = coming < TI;
            const int n = have ? pf.n : 0;
            const int ei = (lane < 32) ? 32 * w + lane : 256 + 32 * w + (lane - 32);
            unsigned ment = 0u; if (ei < n) ment = ((unsigned)(pf.lq * MOBA_BLK + (int)(pf.raw >> 2)) << 2) | (unsigned)(pf.raw & 3);
            const int nw0 = n - 32 * w, nw1 = n - 256 - 32 * w;
            unsigned ea = 0u, eb = 0u; h16x8 ra0, ra1, rb0, rb1;
            if (nw0 > 0) { ea = (unsigned)__shfl((int)ment, fr < nw0 ? fr : nw0 - 1); eb = (unsigned)__shfl((int)ment, 16 + fr < nw0 ? 16 + fr : nw0 - 1);
                const f16_t* pa = P + (size_t)(b * SEQ + (int)(ea >> 2)) * NB + h * HD + 8 * G; const f16_t* pb = P + (size_t)(b * SEQ + (int)(eb >> 2)) * NB + h * HD + 8 * G;
                ra0 = *(const h16x8*)pa; ra1 = *(const h16x8*)(pa + 32); rb0 = *(const h16x8*)pb; rb1 = *(const h16x8*)(pb + 32); }
            __syncthreads();
            if (iter > 0) { it_cur = it_nxt; it_nxt = itq[0]; }
            if (it_cur >= TI) break;
            LAS const unsigned char* Kimg = F.lds + cb * 65536; LAS const unsigned char* Vimg = Kimg + 32768;
            unsigned nn = 0u; if (tid == 0) nn = __hip_atomic_fetch_add(qctr, 1u, RLX_AGENT);
            const int npairs = nw0 <= 0 ? 0 : (nw1 > 0 ? 2 : 1); bool done_pf = false;
            for (int k = 0; k < npairs; ++k) {
                const int nwk = k ? nw1 : nw0;
                const bool va = fr < nwk, vb = 16 + fr < nwk; const unsigned cea = ea, ceb = eb;
                const int ta = (int)(cea >> 2), tb = (int)(ceb >> 2);
                h16x8 qa0, qa1, qb0, qb1; float mba, mbb;
                moba_finish_q(ra0, ra1, maxgk, qa0, qa1, mba); moba_finish_q(rb0, rb1, maxgk, qb0, qb1, mbb);
                if (k + 1 < npairs) {
                    ea = (unsigned)__shfl((int)ment, 32 + (fr < nw1 ? fr : nw1 - 1)); eb = (unsigned)__shfl((int)ment, 32 + (16 + fr < nw1 ? 16 + fr : nw1 - 1));
                    const f16_t* pa = P + (size_t)(b * SEQ + (int)(ea >> 2)) * NB + h * HD + 8 * G; const f16_t* pb = P + (size_t)(b * SEQ + (int)(eb >> 2)) * NB + h * HD + 8 * G;
                    ra0 = *(const h16x8*)pa; ra1 = *(const h16x8*)(pa + 32); rb0 = *(const h16x8*)pb; rb1 = *(const h16x8*)(pb + 32); }
                else { done_pf = true; if (it_nxt < TI) sp_prefetch(it_nxt, bh, IP, NJ, cum, offs, LIST, P, F.lds + (cb ^ 1) * 65536, w, lane, tid, pf); }
                f32x4 oa[4], ob[4]; float lsa = 0.f, lsb = 0.f;
#pragma unroll
                for (int dt = 0; dt < 4; ++dt) { oa[dt] = (f32x4){0.f, 0.f, 0.f, 0.f}; ob[dt] = oa[dt]; }
                if (ENGINE || ESTEPS > 0) attn_tile2<false, true>(Kimg, Vimg, Kimg, Vimg, ENGINE ? MOBA_BLK / 32 : ESTEPS, qa0, qa1, mba, 0, qb0, qb1, mbb, 0, oa, ob, lsa, lsb, lane); else { lsa = mba; lsb = mbb; oa[0][0] = (float)qa0[0] + (float)qa1[1]; ob[0][0] = (float)qb0[0] + (float)qb1[1]; }
                const float ila = 1.0f / lsa, ilb = 1.0f / lsb;
                if (!ENGINE) { asm volatile("" :: "v"(lsa), "v"(lsb), "v"(oa[0][0]), "v"(ob[0][0])); }
                { const size_t pia = ((size_t)bh * SEQ + ta) * 3 + (cea & 3u), pib = ((size_t)bh * SEQ + tb) * 3 + (ceb & 3u);
                  u32x4 sa[2], sb[2];
#pragma unroll
                  for (int pr = 0; pr < 2; ++pr) { const int dt0 = 2 * pr; u32x2 x, y;
                      x.x = pkh(oa[dt0][0] * ila, oa[dt0][1] * ila); x.y = pkh(oa[dt0][2] * ila, oa[dt0][3] * ila); y.x = pkh(oa[dt0 + 1][0] * ila, oa[dt0 + 1][1] * ila); y.y = pkh(oa[dt0 + 1][2] * ila, oa[dt0 + 1][3] * ila); sa[pr] = pair16(x, y);
                      x.x = pkh(ob[dt0][0] * ilb, ob[dt0][1] * ilb); x.y = pkh(ob[dt0][2] * ilb, ob[dt0][3] * ilb); y.x = pkh(ob[dt0 + 1][0] * ilb, ob[dt0 + 1][1] * ilb); y.y = pkh(ob[dt0 + 1][2] * ilb, ob[dt0 + 1][3] * ilb); sb[pr] = pair16(x, y); }
                  if (va && ENGINE) { *(u32x4*)(PO + pia * HD + pair16_dim(G, 0)) = sa[0]; *(u32x4*)(PO + pia * HD + pair16_dim(G, 2)) = sa[1]; if (G == 0) PL[pia] = lsa; }
                  if (vb && ENGINE) { *(u32x4*)(PO + pib * HD + pair16_dim(G, 0)) = sb[0]; *(u32x4*)(PO + pib * HD + pair16_dim(G, 2)) = sb[1]; if (G == 0) PL[pib] = lsb; } }
            }
            if (!done_pf && it_nxt < TI) sp_prefetch(it_nxt, bh, IP, NJ, cum, offs, LIST, P, F.lds + (cb ^ 1) * 65536, w, lane, tid, pf);
            if (tid == 0) itq[0] = (int)nn;
            cb ^= 1;
        }
    }
}

template <bool PR_ENG, bool PR_PART, bool PR_ST>
__device__ __forceinline__ void moba_own(const Frame& F, const Args& a) {
    const f16_t* P = (const f16_t*)(a.ws + WS_P16); f16_t* Y = (f16_t*)(a.ws + WS_Y16);
    const f16_t* PO = (const f16_t*)(a.ws + WS_PO); const float* PL = (const float*)(a.ws + WS_PL);
    const int lane = F.lane, fr = lane & 15, G = lane >> 4, w = F.wave;
    const float maxgk = wave_max(fabsf(a.in[12][lane]));
    for (int up = F.vcu; up < BATCH * MOBA_H * NBLK / 2; up += F.G) {
        const int bh = up / (NBLK / 2), b = bh / MOBA_H, h = bh % MOBA_H, qb0 = 2 * (up % (NBLK / 2));
        __syncthreads();
#pragma unroll
        for (int k = 0; k < 2; ++k) { const f16_t* kb = P + (size_t)(b * SEQ + (qb0 + k) * MOBA_BLK) * NB + MIXW + h * HD;
            dma_kv_imgs(F.lds + k * 65536, F.lds + k * 65536 + 32768, kb, kb + MIXW, w, lane); }
        const int dt0 = w, dt1 = 7 - w;
        const int tq[2][2] = {{qb0 * MOBA_BLK + 32 * dt0 + fr, qb0 * MOBA_BLK + 32 * dt0 + 16 + fr}, {(qb0 + 1) * MOBA_BLK + 32 * dt1 + fr, (qb0 + 1) * MOBA_BLK + 32 * dt1 + 16 + fr}};
        VM_WAIT();
        __syncthreads();
#pragma unroll
        for (int k = 0; k < 2; ++k) {
            const int qb = qb0 + k, nsel = qb < 3 ? qb : 3, dti = k ? dt1 : dt0;
            const int ta = tq[k][0], tb = tq[k][1];
            h16x8 q0[2][2], q1[2][2]; float mb[2][2];
#pragma unroll
            for (int t = 0; t < 2; ++t) moba_load_q(P + (size_t)(b * SEQ + tq[k][t]) * NB + h * HD, G, maxgk, q0[k][t], q1[k][t], mb[k][t]);
            f32x4 oa[4], ob[4]; float lsa = 0.f, lsb = 0.f;
#pragma unroll
            for (int dt = 0; dt < 4; ++dt) { oa[dt] = (f32x4){0.f, 0.f, 0.f, 0.f}; ob[dt] = oa[dt]; }
            LAS const unsigned char* Ki = F.lds + k * 65536;
            if (PR_ENG) attn_tile2<true, true>(Ki, Ki + 32768, Ki, Ki + 32768, dti + 1, q0[k][0], q1[k][0], mb[k][0], 32 * dti + fr, q0[k][1], q1[k][1], mb[k][1], 32 * dti + 16 + fr, oa, ob, lsa, lsb, lane); else { lsa = mb[k][0] + (float)q0[k][0][0] + (float)q1[k][0][1]; lsb = mb[k][1] + (float)q0[k][1][0] + (float)q1[k][1][1]; }
            float pl[2][3]; u32x4 pw[2][3][2];
#pragma unroll
            for (int slot = 0; slot < 3; ++slot) if (PR_PART && slot < nsel) {
                const size_t pia = ((size_t)bh * SEQ + ta) * 3 + slot, pib = ((size_t)bh * SEQ + tb) * 3 + slot;
                pl[0][slot] = __builtin_nontemporal_load(PL + pia); pl[1][slot] = __builtin_nontemporal_load(PL + pib);
#pragma unroll
                for (int pr = 0; pr < 2; ++pr) { pw[0][slot][pr] = __builtin_nontemporal_load((const u32x4*)(PO + pia * HD + pair16_dim(G, 2 * pr))); pw[1][slot][pr] = __builtin_nontemporal_load((const u32x4*)(PO + pib * HD + pair16_dim(G, 2 * pr))); } }
#pragma unroll
            for (int slot = 0; slot < 3; ++slot) if (PR_PART && slot < nsel) {
#pragma unroll
                for (int pr = 0; pr < 2; ++pr) { u32x2 xa, ya, xb, yb; unpair16(pw[0][slot][pr], xa, ya); unpair16(pw[1][slot][pr], xb, yb);
                    const h16x4 va0 = __builtin_bit_cast(h16x4, xa), va1 = __builtin_bit_cast(h16x4, ya), vb0 = __builtin_bit_cast(h16x4, xb), vb1 = __builtin_bit_cast(h16x4, yb);
#pragma unroll
                    for (int e = 0; e < 4; ++e) { oa[2 * pr][e] += pl[0][slot] * (float)va0[e]; oa[2 * pr + 1][e] += pl[0][slot] * (float)va1[e]; ob[2 * pr][e] += pl[1][slot] * (float)vb0[e]; ob[2 * pr + 1][e] += pl[1][slot] * (float)vb1[e]; } }
                lsa += pl[0][slot]; lsb += pl[1][slot]; }
            const float ila = 1.0f / lsa, ilb = 1.0f / lsb;
            if (PR_ST) { store_o8((unsigned char*)Y + (size_t)(b * SEQ + ta) * DM + h * HD, oa, ila, G); store_o8((unsigned char*)Y + (size_t)(b * SEQ + tb) * DM + h * HD, ob, ilb, G); }
            else asm volatile("" :: "v"(oa[0][0] * ila), "v"(ob[0][0] * ilb));
        }
    }
}
__device__ __forceinline__ void xattn_b(const Frame& F, const Args& a) {
    const f16_t* P = (const f16_t*)(a.ws + WS_P16); f16_t* Y = (f16_t*)(a.ws + WS_Y16);
    __syncthreads();
    for (int chunk = F.vcu; chunk < M / CHUNK; chunk += F.G) xattn_chunk<true>(F, a, chunk, P, NB, 3 * MIXW, a.in[16] + HD, Y);
}

__device__ __forceinline__ void ffn_fixup(const Frame& F, const float* bnd_g, const float* cw, const float* cb, f16_t* U) {
    constexpr int HALF = pg8::HALF, NNU = FF2 / 256, TOTAL = (M / 256) * NNU * HALF, NIT = 3;
    const int stride = F.G * (NWAVES * 64);
    for (int base = F.vcu * (NWAVES * 64) + F.tid; base < TOTAL; base += NIT * stride) {
    float x[NIT][2][4], wv[NIT][2][4];
#pragma unroll
    for (int k = 0; k < NIT; ++k) {
        const int idx = base + k * stride, id2 = idx < TOTAL ? idx : 0;
        const int j = id2 & (HALF - 1), unit = id2 >> 7, pm = unit / NNU, pn = unit % NNU;
        const float* own = bnd_g + (size_t)unit * 1024; const bool first = (pm % (SEQ / 256)) == 0; const float* prv = first ? own : own - (size_t)NNU * 1024;
#pragma unroll
        for (int part = 0; part < 2; ++part) {
            const int c = part * HALF + j, gc = part * FF + pn * HALF + j;
            const float a2 = prv[2 * 256 + c], a1 = prv[3 * 256 + c];
            x[k][part][0] = first ? 0.f : a2; x[k][part][1] = first ? 0.f : a1; x[k][part][2] = own[c]; x[k][part][3] = own[256 + c];
            wv[k][part][0] = cw[gc]; wv[k][part][1] = cw[FF2 + gc]; wv[k][part][2] = cw[2 * FF2 + gc]; wv[k][part][3] = cb[gc];
        }
    }
#pragma unroll
    for (int k = 0; k < NIT; ++k) {
        const int idx = base + k * stride; if (idx >= TOTAL) break;
        const int j = idx & (HALF - 1), unit = idx >> 7, pm = unit / NNU, pn = unit % NNU;
        float h0[2], h1[2];
#pragma unroll
        for (int part = 0; part < 2; ++part) {
            h0[part] = fmaf(wv[k][part][0], x[k][part][0], fmaf(wv[k][part][1], x[k][part][1], fmaf(wv[k][part][2], x[k][part][2], wv[k][part][3])));
            h1[part] = fmaf(wv[k][part][0], x[k][part][1], fmaf(wv[k][part][1], x[k][part][2], fmaf(wv[k][part][2], x[k][part][3], wv[k][part][3])));
        }
        f16_t* up = U + (size_t)(pm * 256) * FF + pn * HALF + j;
        up[0] = f2h(gelu_tanh(h0[0]) * h0[1]); up[FF] = f2h(gelu_tanh(h1[0]) * h1[1]);
    }
    }
}

__global__ void __launch_bounds__(NWAVES * 64, 2) fwd_kernel(Args args) {
    extern __shared__ __attribute__((aligned(16))) unsigned char lds_raw[];
    Frame F;
    F.lds = (LAS unsigned char*)lds_raw;
    F.MISC = (volatile LAS unsigned*)(F.lds + MISC_OFF);
    F.tid = threadIdx.x; F.lane = F.tid & 63; F.wave = __builtin_amdgcn_readfirstlane(F.tid >> 6);
    F.G = gridDim.x; { const int bx = blockIdx.x; F.vcu = (F.G % 8 == 0) ? (bx % 8) * (F.G / 8) + bx / 8 : bx; }
    unsigned char* ws = args.ws;
    F.ctl = (gu32*)(ws + WS_CTL);
    for (int u = F.tid; u < 64; u += NWAVES * 64) ((LAS unsigned*)(F.lds + MISC_OFF))[u] = 0u;
    __syncthreads();
    const int lo = args.ph_lo, hi = args.ph_hi;
    XcdBarrier bar; bar.bar = (unsigned*)(F.ctl + CW_BAR); bar.x = 0; bar.st = nullptr;
    if (hi - lo > 1) bar = xcd_barrier_post((unsigned*)(F.ctl + CW_BAR), F.MISC + 8);
#define IN(k) (lo <= (k) && (k) < hi)
#ifndef PROBE_BARX
#define PROBE_BARX 0
#endif
#define SEAM(k) do { if (IN(k) && IN((k) + 1)) { xcd_barrier(bar); if (PROBE_BARX && (k) == 2) { for (int r_ = 0; r_ < 10; ++r_) xcd_barrier(bar); } } } while (0)
    LAS unsigned char* ring = F.lds; LAS unsigned char* xl = F.lds + XCH_OFF;
    f16_t* A16 = (f16_t*)(ws + WS_A16); f16_t* Y16 = (f16_t*)(ws + WS_Y16); f16_t* P16 = (f16_t*)(ws + WS_P16);
    float* SS0 = (float*)(F.ctl + CW_SS0); float* SSV = (float*)(F.ctl + CW_SSV); float* SS1 = (float*)(F.ctl + CW_SS1); float* SS2 = (float*)(F.ctl + CW_SS2); float* SS3 = (float*)(F.ctl + CW_SS3);
    float* KMEAN = (float*)(F.ctl + CW_KMEAN);
    const int c = (int)blockIdx.x;

#ifndef PROBE_DUP
#define PROBE_DUP -1
#endif
#define RUNS(k) for (int rep = 0; rep < (((k) == PROBE_DUP) ? 2 : 1); ++rep)
    if (IN(0)) { RUNS(0) p0_prologue(F, args); } SEAM(0);
    if (IN(1)) { { pg8::Gemm g{(const f16_t*)(ws + WS_MEM16), (const f16_t*)(ws + WS_WKV), DM}; pg8::Order S; S.init(2, 2, F.G, (c + 4) % F.G, 0);
        pg8::EpiKV E{(f16_t*)(ws + WS_KM16), (f16_t*)(ws + WS_VM16), (const float*)(F.ctl + CW_SSM), args.in[15]}; pg8::gemm_phase<pg8::EpiKV, true>(ring, xl, g, S, E); }
      RUNS(1) { pg8::Gemm g{A16, (const f16_t*)(ws + WS_WINA), DM}; pg8::Order S; S.init(M / 256, NA / 256, F.G, c, 0);
        pg8::EpiInA E{P16, SS0, SSV, rep > 0}; pg8::gemm_phase<pg8::EpiInA, true>(ring, xl, g, S, E); }
      { int ilo = ((M / 256) * (NA / 256)) % F.G, ihi = F.G - 4; if (ihi - ilo < 8) { ilo = 0; ihi = F.G; }
        if (c >= ilo && c < ihi) { __syncthreads(); p0_late_weights(F, args, (c - ilo) * NWAVES + F.wave, (ihi - ilo) * NWAVES); __syncthreads(); } } } SEAM(1);
#ifndef PROBE_P2
#define PROBE_P2 0
#endif
    if (IN(2)) { mixer_a<true, true>(F, args); if (PROBE_P2 == 1) mixer_a<true, false>(F, args); if (PROBE_P2 == 2) mixer_a<false, true>(F, args); } SEAM(2);
    if (IN(3)) { RUNS(3) { pg8::Gemm g{Y16, (const f16_t*)(ws + WS_WOUTA), DM}; pg8::Order S; S.init(M / 256, DM / 256, F.G, c, 0);
        pg8::EpiRes E{A16, nullptr, SS1, rep > 0, nullptr, 1.0f}; pg8::gemm_phase<pg8::EpiRes, true>(ring, xl, g, S, E); } } SEAM(3);
    float* BNDG = (float*)(ws + WS_Y16);
    if (IN(4)) { RUNS(4) { pg8::Gemm g{A16, (const f16_t*)(ws + WS_WUP0), DM}; pg8::Order S; S.init(M / 256, FF2 / 256, F.G, c, 0);
        pg8::EpiUp E{P16, SS1, args.in[18], args.in[19], BNDG}; pg8::gemm_phase<pg8::EpiUp, true>(ring, xl, g, S, E); }
      if (hi - lo > 1) xcd_barrier(bar);
      ffn_fixup(F, BNDG, args.in[18], args.in[19], P16);
#ifdef PROBE_NULL4
      { pg8::Gemm g{A16, (const f16_t*)(ws + WS_WUP0), DM}; pg8::Order S; S.init(M / 256, FF2 / 256, F.G, c, 0); pg8::EpiNull E{}; pg8::gemm_phase<pg8::EpiNull, true>(ring, xl, g, S, E); }
#endif
    } SEAM(4);
    if (IN(5)) { RUNS(5) { pg8::Gemm g{P16, (const f16_t*)(ws + WS_WDN0), FF}; pg8::Order S; S.init(M / 256, DM / 256, F.G, c, 0);
        pg8::EpiRes E{A16, nullptr, SS2, rep > 0, ws + WS_PO  , 1.0f}; pg8::gemm_phase<pg8::EpiRes, true>(ring, xl, g, S, E); } } SEAM(5);
    if (IN(6)) { RUNS(6) { pg8::Gemm g{(const f16_t*)(ws + WS_PO), (const f16_t*)(ws + WS_WINB), DM / 2};   pg8::Order S; S.init(M / 256, NB / 256, F.G, c, 0);
        pg8::EpiInB E{P16, SS2, args.in[11], args.in[12], KMEAN, rep > 0, 1.0f / (F8_SA * F8_SW)}; pg8::gemm_phase<pg8::EpiInB, true, true>(ring, xl, g, S, E); } } SEAM(6);
#ifndef PROBE_P7
#define PROBE_P7 0
#endif
    if (IN(7)) { moba_select(F, args); xattn_b(F, args); if (PROBE_P7 == 1) moba_select(F, args); if (PROBE_P7 == 2) xattn_b(F, args); } SEAM(7);
#ifndef PROBE_SPARSE_NOENG
#define PROBE_SPARSE_NOENG 0
#endif
#ifndef PROBE_ESTEPS
#define PROBE_ESTEPS 0
#endif
    if (IN(8)) { moba_sparse<true, 8>(F, args, 0); if (PROBE_SPARSE_NOENG) moba_sparse<false, PROBE_ESTEPS>(F, args, 1); else if (PROBE_DUP == 8) moba_sparse<true, 8>(F, args, 1); } SEAM(8);
#ifndef PROBE_OWN
#define PROBE_OWN 0
#endif
    if (IN(9)) { moba_own<true, true, true>(F, args); if (PROBE_OWN == 1) moba_own<true, true, false>(F, args); if (PROBE_OWN == 2) moba_own<false, true, false>(F, args); if (PROBE_OWN == 3) moba_own<true, false, false>(F, args); if (PROBE_OWN == 4) moba_own<false, false, false>(F, args); } SEAM(9);
    if (IN(10)) { RUNS(10) { pg8::Gemm g{Y16, (const f16_t*)(ws + WS_WOUTB), DM / 2};   pg8::Order S; S.init(M / 256, DM / 256, F.G, c, 0);
        pg8::EpiRes E{A16, nullptr, SS3, rep > 0, nullptr, 1.0f / (F8_SY * F8_SW)}; pg8::gemm_phase<pg8::EpiRes, true, true>(ring, xl, g, S, E); } } SEAM(10);
    if (IN(11)) { RUNS(11) { pg8::Gemm g{A16, (const f16_t*)(ws + WS_WUP1), DM}; pg8::Order S; S.init(M / 256, FF2 / 256, F.G, c, 0);
        pg8::EpiUp E{P16, SS3, args.in[18] + 3 * FF2, args.in[19] + FF2, BNDG}; pg8::gemm_phase<pg8::EpiUp, true>(ring, xl, g, S, E); }
      if (hi - lo > 1) xcd_barrier(bar);
      ffn_fixup(F, BNDG, args.in[18] + 3 * FF2, args.in[19] + FF2, P16); } SEAM(11);
    if (IN(12)) { RUNS(12) { pg8::Gemm g{P16, (const f16_t*)(ws + WS_WDN1), FF}; pg8::Order S; S.init(M / 256, DM / 256, F.G, c, 0);
        pg8::EpiRes E{A16, args.out, nullptr, rep > 0, nullptr, 1.0f}; pg8::gemm_phase<pg8::EpiRes, true>(ring, xl, g, S, E); } }
#undef IN
#undef SEAM
}

extern "C" void kernel_launch(void* const* d_in, const int* in_sizes, int n_in, void* d_out, int out_size, void* d_ws, size_t ws_size, hipStream_t stream) {
    static int grid = 0;
    if (grid == 0) {
        if (n_in != 21 || in_sizes[0] != M * DM || out_size != M * DM || ws_size < WS_END) { fprintf(stderr, "kernel_launch: unexpected shapes (n_in %d, in0 %d, out %d, ws %zu); nothing launched\n", n_in, n_in > 0 ? in_sizes[0] : -1, out_size, ws_size); grid = -1; return; }
        int dev = 0, cus = 0;
        if (hipGetDevice(&dev) != hipSuccess || hipDeviceGetAttribute(&cus, hipDeviceAttributeMultiprocessorCount, dev) != hipSuccess) { grid = -1; return; }
        if (hipFuncSetAttribute((const void*)fwd_kernel, hipFuncAttributeMaxDynamicSharedMemorySize, LDS_BYTES) != hipSuccess) { fprintf(stderr, "kernel_launch: hipFuncSetAttribute failed\n"); grid = -1; return; }
        (void)hipGetLastError();
        grid = cus;
    }
    if (grid < 0) return;
    if (hipMemsetAsync((char*)d_ws + WS_CTL, 0, CTL_BYTES, stream) != hipSuccess) return;
    Args a{};
    for (int i = 0; i < 21; ++i) a.in[i] = (const float*)d_in[i];
    a.out = (float*)d_out; a.ws = (unsigned char*)d_ws;
#if MK_ONE_LAUNCH
    a.ph_lo = 0; a.ph_hi = 13;
    hipLaunchKernelGGL(fwd_kernel, dim3(grid), dim3(NWAVES * 64), LDS_BYTES, stream, a);
#else
    for (int p = 0; p < 13; ++p) { a.ph_lo = p; a.ph_hi = p + 1; hipLaunchKernelGGL(fwd_kernel, dim3(grid), dim3(NWAVES * 64), LDS_BYTES, stream, a); }
#endif
}
```

```cpp
#include <hip/hip_runtime.h>
#include <cstdio>
#include <cstdint>

#ifndef MK_ONE_LAUNCH
#define MK_ONE_LAUNCH 1
#endif

#define LAS __attribute__((address_space(3)))
#define GAS __attribute__((address_space(1)))
typedef unsigned short f16_t;
typedef _Float16 h16x8 __attribute__((ext_vector_type(8)));
typedef _Float16 h16x4 __attribute__((ext_vector_type(4)));
typedef _Float16 h16x2 __attribute__((ext_vector_type(2)));
typedef float f32x4 __attribute__((ext_vector_type(4)));
typedef float f32x2 __attribute__((ext_vector_type(2)));
typedef unsigned u32x4 __attribute__((ext_vector_type(4)));
typedef unsigned u32x2 __attribute__((ext_vector_type(2)));
typedef GAS unsigned gu32;

constexpr int BATCH = 2, SEQ = 16384, DM = 1024, M = BATCH * SEQ;
constexpr int MIXW = 768, MEMW = 256, NA = 2 * MIXW + MEMW  , NB = 3 * MIXW + MEMW  ;
constexpr int FF = 2816, FF2 = 5632, NMEM = 256, HD = 64;
constexpr int CHUNK = 128, NGRP = 6, MOBA_H = 12, MOBA_BLK = 256, NBLK = SEQ / MOBA_BLK  ;
constexpr float EPS = 1e-6f;
constexpr int UP_UNITS_PER_BATCH = 69;

constexpr size_t MiB = 1u << 20;
constexpr size_t WS_CTL = 0, CTL_BYTES = 2 * MiB;
constexpr size_t WS_WINA = 2 * MiB, WS_WOUTA = 6 * MiB, WS_WINB = 8 * MiB, WS_WOUTB = 13 * MiB;
constexpr size_t WS_WUP0 = 15 * MiB, WS_WUP1 = 26 * MiB, WS_WDN0 = 37 * MiB, WS_WDN1 = 43 * MiB, WS_KV = 49 * MiB, WS_KM16 = 50 * MiB, WS_VM16 = 51 * MiB, WS_LIST = 52 * MiB, WS_OFFS = 55 * MiB, WS_PL = 56 * MiB, WS_MEM16 = 61 * MiB, WS_WKV = 62 * MiB, WS_W16S = 63 * MiB;
constexpr size_t WS_A16 = 64 * MiB, WS_Y16 = 128 * MiB, WS_P16 = 192 * MiB, WS_PO = 368 * MiB, WS_END = 512 * MiB;
constexpr int CW_TMO = 0, CW_BAR = 4096, CW_QUEUE = 8192;
constexpr int CW_SS0 = 16384, CW_SSV = CW_SS0 + M, CW_SS1 = CW_SSV + M, CW_SS2 = CW_SS1 + M, CW_SS3 = CW_SS2 + M;
constexpr int CW_SSM = CW_SS3 + M;
constexpr int CW_KMEAN = CW_SSM + 512;
static_assert((size_t)(CW_KMEAN + BATCH * MOBA_H * NBLK * HD) * 4 <= CTL_BYTES, "ctl");

constexpr int RING_BYTES = 131072, XCH_OFF = RING_BYTES, XCH_BYTES = 16384, MISC_OFF = 163840 - 256;
constexpr int LDS_BYTES = 163840;
constexpr int NWAVES = 8;

#define LDS_WAIT() asm volatile("s_waitcnt lgkmcnt(0)" ::: "memory")
#define VM_WAIT() asm volatile("s_waitcnt vmcnt(0)" ::: "memory")
#define RLX_AGENT __ATOMIC_RELAXED, __HIP_MEMORY_SCOPE_AGENT

__device__ __forceinline__ unsigned pkh(float lo, float hi) { f32x2 v = {lo, hi}; h16x2 h = __builtin_convertvector(v, h16x2); return __builtin_bit_cast(unsigned, h); }
__device__ __forceinline__ unsigned pk8(float a, float b, float c, float d) { int w = __builtin_amdgcn_cvt_pk_fp8_f32(a, b, 0, false); w = __builtin_amdgcn_cvt_pk_fp8_f32(c, d, w, true); return (unsigned)w; }
constexpr float F8_SA = 8.0f, F8_SW = 512.0f, F8_SY = 32.0f;
__device__ __forceinline__ float h2f(f16_t b) { return (float)__builtin_bit_cast(_Float16, b); }
__device__ __forceinline__ f16_t f2h(float f) { return __builtin_bit_cast(f16_t, (_Float16)f); }
__device__ __forceinline__ float gelu_tanh(float x) {
    const float u = x * (1.0f + 0.044715f * x * x);
    const float e = __builtin_amdgcn_exp2f(u * (-2.0f * 0.7978845608028654f * 1.4426950408889634f));
    return x * __builtin_amdgcn_rcpf(1.0f + e);
}
__device__ __forceinline__ f32x2 gelu_tanh2(f32x2 x) {
    constexpr float C = -2.0f * 0.7978845608028654f * 1.4426950408889634f;
    const f32x2 t = (x * x) * (0.044715f * C) + C;
    const f32x2 a = x * t;
    f32x2 e; e.x = __builtin_amdgcn_exp2f(a.x); e.y = __builtin_amdgcn_exp2f(a.y);
    const f32x2 d = e + 1.0f;
    f32x2 r; r.x = __builtin_amdgcn_rcpf(d.x); r.y = __builtin_amdgcn_rcpf(d.y);
    return x * r;
}
__device__ __forceinline__ float wave_sum(float v) {
#pragma unroll
    for (int o = 1; o < 64; o <<= 1) v += __shfl_xor(v, o);
    return v;
}

namespace pg8 {
constexpr int BM = 256, BK = 64, HALF = 128, HTB = HALF * BK * 2, STAGE_BYTES = 8 * HTB, NXCD = 8, WGM = 8;
__host__ __device__ __forceinline__ int lds_byte(int r, int c) { const int st = (r >> 4) * 2 + (c >> 5), rr = r & 15, cc = c & 31, ob = rr * 64 + cc * 2; return st * 1024 + (ob ^ (((ob >> 9) & 1) << 5)); }
__host__ __device__ __forceinline__ void stage_rc(int b, int& R, int& C) { const int st = b / 1024, sb = b % 1024, swz = sb ^ (((sb >> 9) & 1) << 5); R = (st >> 1) * 16 + swz / 64; C = (st & 1) * 32 + (swz % 64) / 2; }
__host__ __device__ __forceinline__ int perm32(int rho) { const int n = rho >> 4, i = rho & 15; return 8 * (i >> 2) + 4 * n + (i & 3); }

struct Unit { int pm, pn; };
struct Gemm { const f16_t* A; const f16_t* Bt; int K; };

struct Order {
    int nM, nN, nwg, G, c, mode;
    __device__ void init(int nM_, int nN_, int G_, int c_, int mode_) { nM = nM_; nN = nN_; nwg = nM * nN; G = G_; c = c_; mode = mode_; }
    __device__ bool next(int i, Unit& u) const {
        const long L = (long)i * G + c; if (L >= nwg) return false;
        int wgid = (int)L; { const int q = nwg / NXCD, r = nwg % NXCD, xcd = wgid % NXCD, off = wgid / NXCD; wgid = (xcd < r ? xcd * (q + 1) : r * (q + 1) + (xcd - r) * q) + off; }
        const int nig = WGM * nN, gid = wgid / nig, fm = gid * WGM, gsz = (nM - fm) < WGM ? (nM - fm) : WGM;
        u.pm = fm + ((wgid % nig) % gsz); u.pn = (wgid % nig) / gsz; return true;
    }
    __device__ __forceinline__ int arow(int pm) const {
        if (mode == 0) return pm * BM;
        const int b = pm / UP_UNITS_PER_BATCH, i = pm % UP_UNITS_PER_BATCH; int s = (i == 0) ? 0 : 240 * i; if (s > SEQ - 256) s = SEQ - 256; return b * SEQ + s;
    }
    __device__ __forceinline__ int out_lo(int pm) const { return (mode == 0 || (pm % UP_UNITS_PER_BATCH) == 0) ? 0 : 16; }
};

typedef int i32x8 __attribute__((ext_vector_type(8)));
__device__ __forceinline__ i32x8 cat_frag(h16x8 a, h16x8 b) { const u32x4 x = __builtin_bit_cast(u32x4, a), y = __builtin_bit_cast(u32x4, b); return (i32x8){(int)x.x, (int)x.y, (int)x.z, (int)x.w, (int)y.x, (int)y.y, (int)y.z, (int)y.w}; }
template <class Epi, bool ALIGN_EPI, bool FP8 = false>
__device__ __forceinline__ void gemm_phase(LAS unsigned char* lds, LAS unsigned char* xl, const Gemm g, const Order& S, const Epi& E) {
    const int tid = threadIdx.x, wid = __builtin_amdgcn_readfirstlane(tid >> 6), lane = tid & 63, wr = wid >> 2, wc = wid & 3, fr = lane & 15, fq = lane >> 4;
    const int K = g.K, nt = K / BK;
    unsigned voffA[2], voffB[2];
#pragma unroll
    for (int i = 0; i < 2; ++i) { int R, C; stage_rc(tid * 16 + i * 8192, R, C); const int Rb = Epi::PERM ? ((R & ~31) + perm32(R & 31)) : R;
        const int Ra = Epi::PERMA ? ((R & ~63) + 4 * (R & 15) + ((R >> 4) & 3)) : R;
        voffA[i] = (unsigned)(Ra * K + C) * 2u; voffB[i] = (unsigned)(Rb * K + C) * 2u; }
    const size_t kstep = (size_t)(BK * 2);
    const size_t hstep = (size_t)HALF * K * 2;
    const size_t tstep = 2 * hstep;
    const size_t rstep = (size_t)K * 2;
    const unsigned ldsw = (unsigned)wid * 1024u;
    const int aoff = lds_byte(wr * 64 + fr, fq * 8), boff = lds_byte(wc * 32 + fr, fq * 8);
#define PG8_SA(b, h) (((b) * 2 + (h)) * HTB)
#define PG8_SB(b, h) ((4 + (b) * 2 + (h)) * HTB)
#define PG8_STAGE(bufoff, gbase, voff) do { _Pragma("unroll") for (int _i = 0; _i < 2; ++_i) \
        __builtin_amdgcn_global_load_lds((const unsigned*)((const char*)(gbase) + (voff)[_i]), (LAS unsigned*)(lds + (bufoff) + ldsw + _i * 8192), 16, 0, 0); } while (0)
#define PG8_LDA(dst, b, h) do { _Pragma("unroll") for (int m = 0; m < 4; ++m) _Pragma("unroll") for (int k = 0; k < 2; ++k) dst[m][k] = *(const LAS h16x8*)(lds + PG8_SA(b, h) + aoff + m * 2048 + k * 1024); } while (0)
#define PG8_LDB(dst, b, h) do { _Pragma("unroll") for (int n = 0; n < 2; ++n) _Pragma("unroll") for (int k = 0; k < 2; ++k) dst[n][k] = *(const LAS h16x8*)(lds + PG8_SB(b, h) + boff + n * 2048 + k * 1024); } while (0)
#define PG8_MMA(ai, bj, At, Bt) do { __builtin_amdgcn_s_setprio(1); _Pragma("unroll") for (int m = 0; m < 4; ++m) _Pragma("unroll") for (int n = 0; n < 2; ++n) { \
        if constexpr (FP8) asm volatile("v_mfma_scale_f32_16x16x128_f8f6f4 %0, %1, %2, %0, %3, %3 op_sel_hi:[0,0,0]" : "+v"(acc[ai][bj][m][n]) : "v"(cat_frag(Bt[n][0], Bt[n][1])), "v"(cat_frag(At[m][0], At[m][1])), "v"(one8)); \
        else { _Pragma("unroll") for (int k = 0; k < 2; ++k) acc[ai][bj][m][n] = __builtin_amdgcn_mfma_f32_16x16x32_f16(Bt[n][k], At[m][k], acc[ai][bj][m][n], 0, 0, 0); } } __builtin_amdgcn_s_setprio(0); } while (0)
#define PG8_WAIT_V(n) asm volatile("s_waitcnt vmcnt(" #n ")" ::: "memory")
#define PG8_WAIT_L(n) asm volatile("s_waitcnt lgkmcnt(" #n ")" ::: "memory")
#define PG8_BAR __builtin_amdgcn_s_barrier()
#define PG8_SCHED __builtin_amdgcn_sched_barrier(0)
    Unit cur, nxt; int ui = 0;
    if (!S.next(0, cur)) return;
    int one8 = 0x7F7F7F7F; asm volatile("" : "+v"(one8));
    f32x4 acc[2][2][4][2];
#pragma unroll
    for (int a = 0; a < 2; ++a)
#pragma unroll
        for (int b = 0; b < 2; ++b)
#pragma unroll
            for (int m = 0; m < 4; ++m)
#pragma unroll
                for (int n = 0; n < 2; ++n) acc[a][b][m][n] = (f32x4){0.f, 0.f, 0.f, 0.f};
    h16x8 At[4][2], B0[2][2], B1[2][2];
    const char* cA = (const char*)g.A + (size_t)S.arow(cur.pm) * rstep; const char* cB = (const char*)g.Bt + (size_t)cur.pn * tstep;
    PG8_STAGE(PG8_SB(0, 0), cB, voffB); PG8_STAGE(PG8_SB(0, 1), cB + hstep, voffB); PG8_STAGE(PG8_SA(0, 0), cA, voffA); PG8_STAGE(PG8_SA(0, 1), cA + hstep, voffA);
    if (wr == 1) PG8_BAR;
    PG8_WAIT_V(2); PG8_BAR;
    PG8_STAGE(PG8_SB(1, 0), cB + kstep, voffB); PG8_STAGE(PG8_SA(1, 0), cA + kstep, voffA); PG8_STAGE(PG8_SB(1, 1), cB + hstep + kstep, voffB);
    PG8_WAIT_V(6); PG8_BAR;
    for (;;) {
        const bool has_next = S.next(ui + 1, nxt);
        E.prefetch(cur, S, xl, ui, wid, lane);
        const char* nA = has_next ? (const char*)g.A + (size_t)S.arow(nxt.pm) * rstep : cA; const char* nB = has_next ? (const char*)g.Bt + (size_t)nxt.pn * tstep : cB;
#pragma unroll 1
        for (int t = 0; t < nt; t += 2) {
            const bool last = (t == nt - 2);
            const char* a1 = cA + (size_t)(t + 1) * kstep;
            const char* a2 = last ? nA : cA + (size_t)(t + 2) * kstep; const char* b2 = last ? nB : cB + (size_t)(t + 2) * kstep;
            const char* a3 = a2 + kstep; const char* b3 = b2 + kstep;
            PG8_LDB(B0, 0, 0); PG8_LDB(B1, 0, 1); PG8_SCHED; PG8_LDA(At, 0, 0); PG8_STAGE(PG8_SA(1, 1), a1 + hstep, voffA);
            PG8_WAIT_V(8); PG8_WAIT_L(0); PG8_BAR; PG8_MMA(0, 0, At, B0); PG8_MMA(0, 1, At, B1); PG8_BAR; PG8_SCHED;
            PG8_LDA(At, 0, 1); PG8_STAGE(PG8_SB(0, 0), b2, voffB); PG8_STAGE(PG8_SB(0, 1), b2 + hstep, voffB); PG8_STAGE(PG8_SA(0, 0), a2, voffA);
            PG8_WAIT_V(8); PG8_WAIT_L(0); PG8_BAR; PG8_MMA(1, 0, At, B0); PG8_MMA(1, 1, At, B1); PG8_BAR; PG8_SCHED;
            PG8_LDB(B0, 1, 0); PG8_LDB(B1, 1, 1); PG8_SCHED; PG8_LDA(At, 1, 0); PG8_STAGE(PG8_SA(0, 1), a2 + hstep, voffA);
            PG8_WAIT_V(8); PG8_WAIT_L(0); PG8_BAR; PG8_MMA(0, 0, At, B0); PG8_MMA(0, 1, At, B1); PG8_BAR; PG8_SCHED;
            PG8_LDA(At, 1, 1); PG8_STAGE(PG8_SB(1, 0), b3, voffB); PG8_STAGE(PG8_SB(1, 1), b3 + hstep, voffB); PG8_STAGE(PG8_SA(1, 0), a3, voffA);
            PG8_WAIT_V(8); PG8_WAIT_L(0); PG8_BAR; PG8_MMA(1, 0, At, B0); PG8_MMA(1, 1, At, B1); PG8_BAR; PG8_SCHED;
        }
        if constexpr (ALIGN_EPI) { if (wr == 0) PG8_BAR; }
        if constexpr (FP8) asm volatile("s_nop 15\n\ts_nop 15" ::: "memory");
        E(acc, cur, S, wr, wc, fr, fq, xl, ui);
        if (!has_next) break;
#pragma unroll
        for (int a = 0; a < 2; ++a)
#pragma unroll
            for (int b = 0; b < 2; ++b)
#pragma unroll
                for (int m = 0; m < 4; ++m)
#pragma unroll
                    for (int n = 0; n < 2; ++n) acc[a][b][m][n] = (f32x4){0.f, 0.f, 0.f, 0.f};
        cur = nxt; cA = nA; cB = nB; ++ui;
        if constexpr (ALIGN_EPI) { if (wr == 1) PG8_BAR; }
    }
    PG8_WAIT_V(0);
    if constexpr (!ALIGN_EPI) { if (wr == 0) PG8_BAR; }
    PG8_BAR;
#undef PG8_SA
#undef PG8_SB
#undef PG8_STAGE
#undef PG8_LDA
#undef PG8_LDB
#undef PG8_MMA
#undef PG8_WAIT_V
#undef PG8_WAIT_L
#undef PG8_BAR
#undef PG8_SCHED
}

struct EpiInA {
    static constexpr bool PERM = true; static constexpr bool PERMA = false;
    f16_t* P; const float* ss_in; float* ssv; bool dry;
    __device__ __forceinline__ void prefetch(const Unit&, const Order&, LAS unsigned char*, int, int, int) const {}
    __device__ __forceinline__ void operator()(f32x4 (&acc)[2][2][4][2], const Unit& u, const Order& S, int wr, int wc, int fr_, int fq_, LAS unsigned char*, int) const {
        int fr = fr_, fq = fq_; asm volatile("" : "+v"(fr), "+v"(fq));
        const int row0 = u.pm * BM + wr * 64 + fr, col0 = u.pn * BM + wc * 32 + 8 * fq;
        const bool act = u.pn < 6, stat = (u.pn >= 3 && u.pn < 6);
#pragma unroll
        for (int ai = 0; ai < 2; ++ai)
#pragma unroll
            for (int m = 0; m < 4; ++m) {
                const int row = row0 + ai * HALF + m * 16;
                const float sc = __builtin_amdgcn_rsqf(ss_in[row] * (1.0f / DM) + EPS);
                float sq = 0.f;
#pragma unroll
                for (int bj = 0; bj < 2; ++bj) {
                    f32x4 v0 = acc[ai][bj][m][0] * sc, v1 = acc[ai][bj][m][1] * sc;
                    if (act) { const f32x2 a0 = gelu_tanh2((f32x2){v0[0], v0[1]}), a1 = gelu_tanh2((f32x2){v0[2], v0[3]}), a2 = gelu_tanh2((f32x2){v1[0], v1[1]}), a3 = gelu_tanh2((f32x2){v1[2], v1[3]});
                        v0 = (f32x4){a0.x, a0.y, a1.x, a1.y}; v1 = (f32x4){a2.x, a2.y, a3.x, a3.y}; }
                    sq += (v0[0] * v0[0] + v0[1] * v0[1]) + (v0[2] * v0[2] + v0[3] * v0[3]) + (v1[0] * v1[0] + v1[1] * v1[1]) + (v1[2] * v1[2] + v1[3] * v1[3]);
                    u32x4 w; w.x = pkh(v0[0], v0[1]); w.y = pkh(v0[2], v0[3]); w.z = pkh(v1[0], v1[1]); w.w = pkh(v1[2], v1[3]);
                    *(u32x4*)(P + (size_t)row * NA + col0 + bj * HALF) = w;
                }
                if (stat && !dry) { sq += __shfl_xor(sq, 16); sq += __shfl_xor(sq, 32); if (fq == 0) atomicAdd(ssv + row, sq); }
            }
    }
};
struct EpiRes {
    static constexpr bool PERM = true; static constexpr bool PERMA = false;
    f16_t* h16; float* out32; float* ss_out; bool dry; unsigned char* h8; float pre;
    __device__ __forceinline__ void prefetch(const Unit&, const Order&, LAS unsigned char*, int, int, int) const {}
    __device__ __forceinline__ void operator()(f32x4 (&acc)[2][2][4][2], const Unit& u, const Order& S, int wr, int wc, int fr_, int fq_, LAS unsigned char*, int) const {
        int fr = fr_, fq = fq_; asm volatile("" : "+v"(fr), "+v"(fq));
        const int row0 = u.pm * BM + wr * 64 + fr, col0 = u.pn * BM + wc * 32 + 8 * fq;
#pragma unroll
        for (int ai = 0; ai < 2; ++ai)
#pragma unroll
            for (int m = 0; m < 4; ++m) {
                const int row = row0 + ai * HALF + m * 16; const size_t off = (size_t)row * DM + col0;
                float sq = 0.f;
#pragma unroll
                for (int bj = 0; bj < 2; ++bj) {
                    const h16x8 bs = *(const h16x8*)(h16 + off + bj * HALF);
                    f32x4 o0 = acc[ai][bj][m][0] * pre, o1 = acc[ai][bj][m][1] * pre;
#pragma unroll
                    for (int e = 0; e < 4; ++e) { o0[e] += (float)bs[e]; o1[e] += (float)bs[4 + e]; }
                    if (out32) { if (!dry) { __builtin_nontemporal_store(o0, (f32x4*)(out32 + off + bj * HALF)); __builtin_nontemporal_store(o1, (f32x4*)(out32 + off + bj * HALF + 4)); } }
                    else if (!dry) {
                        sq += (o0[0] * o0[0] + o0[1] * o0[1]) + (o0[2] * o0[2] + o0[3] * o0[3]) + (o1[0] * o1[0] + o1[1] * o1[1]) + (o1[2] * o1[2] + o1[3] * o1[3]);
                        u32x4 w; w.x = pkh(o0[0], o0[1]); w.y = pkh(o0[2], o0[3]); w.z = pkh(o1[0], o1[1]); w.w = pkh(o1[2], o1[3]);
                        *(u32x4*)(h16 + off + bj * HALF) = w;
                        if (h8) { u32x2 q; q.x = pk8(o0[0] * F8_SA, o0[1] * F8_SA, o0[2] * F8_SA, o0[3] * F8_SA); q.y = pk8(o1[0] * F8_SA, o1[1] * F8_SA, o1[2] * F8_SA, o1[3] * F8_SA); *(u32x2*)(h8 + off + bj * HALF) = q; } }
                }
                if (!out32 && !dry) { sq += __shfl_xor(sq, 16); sq += __shfl_xor(sq, 32); if (fq == 0) atomicAdd(ss_out + row, sq); }
            }
    }
};
__device__ __forceinline__ float dpp_ror1(float v) { return __builtin_bit_cast(float, __builtin_amdgcn_mov_dpp(__builtin_bit_cast(int, v), 0x121, 0xf, 0xf, false)); }
__device__ __forceinline__ float dpp_ror2(float v) { return __builtin_bit_cast(float, __builtin_amdgcn_mov_dpp(__builtin_bit_cast(int, v), 0x122, 0xf, 0xf, false)); }
__device__ __forceinline__ float dpp_shr1_keep(float keep, float v) { return __builtin_bit_cast(float, __builtin_amdgcn_update_dpp(__builtin_bit_cast(int, keep), __builtin_bit_cast(int, v), 0x111, 0xf, 0xf, false)); }
__device__ __forceinline__ float dpp_shr2_keep(float keep, float v) { return __builtin_bit_cast(float, __builtin_amdgcn_update_dpp(__builtin_bit_cast(int, keep), __builtin_bit_cast(int, v), 0x112, 0xf, 0xf, false)); }
struct EpiUp {
    static constexpr bool PERM = false;
    static constexpr bool PERMA = true;
    f16_t* U; const float* ss_in; const float* cw; const float* cb; float* bnd_g;
    __device__ __forceinline__ void prefetch(const Unit& u, const Order& S, LAS unsigned char* xl, int ui, int wid, int lane) const {
        if (wid >= 5) return;
        LAS unsigned char* dst = xl + 8192 + (ui & 1) * 5120 + wid * 1024;
        const float* src;
        if (wid < 3) src = cw + (size_t)wid * FF2 + (lane >> 5) * FF + u.pn * HALF + 4 * (lane & 31);
        else if (wid == 3) src = cb + (lane >> 5) * FF + u.pn * HALF + 4 * (lane & 31);
        else src = ss_in + S.arow(u.pm) + 4 * lane;
        __builtin_amdgcn_global_load_lds((const unsigned*)src, (LAS unsigned*)dst, 16, 0, 0);
    }
    __device__ __forceinline__ void operator()(f32x4 (&acc)[2][2][4][2], const Unit& u, const Order& S, int wr, int wc, int fr_, int fq_, LAS unsigned char* xl, int ui) const {
        int fr = fr_, fq = fq_; asm volatile("" : "+v"(fr), "+v"(fq));
        const int rs = S.arow(u.pm), lo = 2;
        const int trow0 = wr * 64 + 4 * fr;
        LAS const float* cst = (LAS const float*)(xl + 8192 + (ui & 1) * 5120);
#pragma unroll
        for (int ai = 0; ai < 2; ++ai) {
            const f32x4 ss4 = *(const LAS f32x4*)(cst + 1024 + trow0 + ai * HALF);
#pragma unroll
            for (int m = 0; m < 4; ++m) {
                const float sc = __builtin_amdgcn_rsqf(ss4[m] * (1.0f / DM) + EPS);
#pragma unroll
                for (int bj = 0; bj < 2; ++bj)
#pragma unroll
                    for (int n = 0; n < 2; ++n) acc[ai][bj][m][n] *= sc;
            }
        }
        LAS float* bnd = (LAS float*)xl;
        const int tcol = wc * 32 + 4 * fq;
        if (fr == 15) {
#pragma unroll
            for (int ai = 0; ai < 2; ++ai)
#pragma unroll
                for (int bj = 0; bj < 2; ++bj)
#pragma unroll
                    for (int n = 0; n < 2; ++n) { *(LAS f32x4*)(bnd + ((2 * ai + wr) * 2 + 0) * 256 + bj * HALF + tcol + 16 * n) = acc[ai][bj][2][n]; *(LAS f32x4*)(bnd + ((2 * ai + wr) * 2 + 1) * 256 + bj * HALF + tcol + 16 * n) = acc[ai][bj][3][n]; }
        }
        { float* bq = bnd_g + (size_t)(u.pm * S.nN + u.pn) * 1024 + tcol;
          if (wr == 0 && fr == 0) {
#pragma unroll
              for (int bj = 0; bj < 2; ++bj)
#pragma unroll
                  for (int n = 0; n < 2; ++n) { *(f32x4*)(bq + 0 * 256 + bj * HALF + 16 * n) = acc[0][bj][0][n]; *(f32x4*)(bq + 1 * 256 + bj * HALF + 16 * n) = acc[0][bj][1][n]; } }
          if (wr == 1 && fr == 15) {
#pragma unroll
              for (int bj = 0; bj < 2; ++bj)
#pragma unroll
                  for (int n = 0; n < 2; ++n) { *(f32x4*)(bq + 2 * 256 + bj * HALF + 16 * n) = acc[1][bj][2][n]; *(f32x4*)(bq + 3 * 256 + bj * HALF + 16 * n) = acc[1][bj][3][n]; } } }
        LDS_WAIT(); __builtin_amdgcn_s_barrier(); asm volatile("" ::: "memory");
#pragma unroll
        for (int n = 0; n < 2; ++n) {
            f32x4 w0[2], w1[2], w2[2], bb[2];
#pragma unroll
            for (int bj = 0; bj < 2; ++bj) { const int cc = bj * HALF + tcol + 16 * n;
                w0[bj] = *(const LAS f32x4*)(cst + cc); w1[bj] = *(const LAS f32x4*)(cst + 256 + cc); w2[bj] = *(const LAS f32x4*)(cst + 512 + cc); bb[bj] = *(const LAS f32x4*)(cst + 768 + cc); }
#pragma unroll
            for (int ai = 0; ai < 2; ++ai) {
                const int g = 2 * ai + wr;
                f32x4 h[4][2];
#pragma unroll
                for (int bj = 0; bj < 2; ++bj) {
                    f32x4 r63 = {0.f, 0.f, 0.f, 0.f}, r62 = r63;
                    if (g > 0) { r62 = *(const LAS f32x4*)(bnd + ((g - 1) * 2 + 0) * 256 + bj * HALF + tcol + 16 * n); r63 = *(const LAS f32x4*)(bnd + ((g - 1) * 2 + 1) * 256 + bj * HALF + tcol + 16 * n); }
                    const f32x4 x0 = acc[ai][bj][0][n], x1 = acc[ai][bj][1][n], x2 = acc[ai][bj][2][n], x3 = acc[ai][bj][3][n];
                    f32x4 pm1, pm2;
#pragma unroll
                    for (int e = 0; e < 4; ++e) { pm1[e] = dpp_shr1_keep(r63[e], x3[e]); pm2[e] = dpp_shr1_keep(r62[e], x2[e]); }
                    h[0][bj] = __builtin_elementwise_fma(w0[bj], pm2, __builtin_elementwise_fma(w1[bj], pm1, __builtin_elementwise_fma(w2[bj], x0, bb[bj])));
                    h[1][bj] = __builtin_elementwise_fma(w0[bj], pm1, __builtin_elementwise_fma(w1[bj], x0, __builtin_elementwise_fma(w2[bj], x1, bb[bj])));
                    h[2][bj] = __builtin_elementwise_fma(w0[bj], x0, __builtin_elementwise_fma(w1[bj], x1, __builtin_elementwise_fma(w2[bj], x2, bb[bj])));
                    h[3][bj] = __builtin_elementwise_fma(w0[bj], x1, __builtin_elementwise_fma(w1[bj], x2, __builtin_elementwise_fma(w2[bj], x3, bb[bj])));
                }
#pragma unroll
                for (int m = 0; m < 4; ++m) {
                    f32x4 o; { const f32x2 g0 = gelu_tanh2((f32x2){h[m][0][0], h[m][0][1]}) * (f32x2){h[m][1][0], h[m][1][1]}, g1 = gelu_tanh2((f32x2){h[m][0][2], h[m][0][3]}) * (f32x2){h[m][1][2], h[m][1][3]}; o = (f32x4){g0.x, g0.y, g1.x, g1.y}; }
                    const int trow = trow0 + ai * HALF + m;
                    if (trow >= lo) { u32x2 pk; pk.x = pkh(o[0], o[1]); pk.y = pkh(o[2], o[3]); *(u32x2*)(U + (size_t)(rs + trow) * FF + u.pn * HALF + tcol + 16 * n) = pk; }
                }
            }
        }
    }
};
struct EpiInB {
    static constexpr bool PERM = true; static constexpr bool PERMA = false;
    f16_t* P; const float* ss_in; const float* gq; const float* gk; float* kmean; bool dry; float pre;
    __device__ __forceinline__ void prefetch(const Unit&, const Order&, LAS unsigned char*, int, int, int) const {}
    __device__ __forceinline__ void operator()(f32x4 (&acc)[2][2][4][2], const Unit& u, const Order& S, int wr, int wc, int fr_, int fq_, LAS unsigned char*, int) const {
        int fr = fr_, fq = fq_; asm volatile("" : "+v"(fr), "+v"(fq));
        const int row0 = u.pm * BM + wr * 64 + fr, colh = u.pn * BM + wc * 64;
        const bool nrm = u.pn < 6, isk = (u.pn >= 3 && u.pn < 6);
        f32x4 gv[2][2];
#pragma unroll
        for (int bj = 0; bj < 2; ++bj)
#pragma unroll
            for (int n = 0; n < 2; ++n) gv[bj][n] = nrm ? *(const f32x4*)((isk ? gk : gq) + 32 * bj + 8 * fq + 4 * n) : (f32x4){1.f, 1.f, 1.f, 1.f};
        f32x4 ks[2][2];
#pragma unroll
        for (int bj = 0; bj < 2; ++bj)
#pragma unroll
            for (int n = 0; n < 2; ++n) ks[bj][n] = (f32x4){0.f, 0.f, 0.f, 0.f};
#pragma unroll
        for (int ai = 0; ai < 2; ++ai)
#pragma unroll
            for (int m = 0; m < 4; ++m) {
                const int row = row0 + ai * HALF + m * 16;
                const float sc = __builtin_amdgcn_rsqf(ss_in[row] * (1.0f / DM) + EPS) * pre;
                f32x4 v[2][2]; float sq = 0.f;
#pragma unroll
                for (int bj = 0; bj < 2; ++bj)
#pragma unroll
                    for (int n = 0; n < 2; ++n) { v[bj][n] = acc[ai][bj][m][n] * sc; const f32x4 t = v[bj][n]; sq += (t[0] * t[0] + t[1] * t[1]) + (t[2] * t[2] + t[3] * t[3]); }
                float rn = 1.f;
                if (nrm) { sq += __shfl_xor(sq, 16); sq += __shfl_xor(sq, 32); rn = __builtin_amdgcn_rsqf(sq * (1.0f / HD) + EPS); }
#pragma unroll
                for (int bj = 0; bj < 2; ++bj) {
                    const f32x4 a = v[bj][0] * rn * gv[bj][0], b = v[bj][1] * rn * gv[bj][1];
                    ks[bj][0] += a; ks[bj][1] += b;
                    u32x4 w; w.x = pkh(a[0], a[1]); w.y = pkh(a[2], a[3]); w.z = pkh(b[0], b[1]); w.w = pkh(b[2], b[3]);
                    *(u32x4*)(P + (size_t)row * NB + colh + 32 * bj + 8 * fq) = w;
                }
            }
        if (isk && !dry) {
            const int b = u.pm / NBLK, blk = u.pm % NBLK, h = (u.pn - 3) * 4 + wc;
            float* dst = kmean + ((size_t)(b * MOBA_H + h) * NBLK + blk) * HD;
#pragma unroll
            for (int bj = 0; bj < 2; ++bj)
#pragma unroll
                for (int n = 0; n < 2; ++n)
#pragma unroll
                    for (int e = 0; e < 4; ++e) {
                        float s = ks[bj][n][e];
                        s += __shfl_xor(s, 1); s += __shfl_xor(s, 2); s += __shfl_xor(s, 4); s += __shfl_xor(s, 8);
                        if (fr == 0) atomicAdd(dst + 32 * bj + 8 * fq + 4 * n + e, s);
                    }
        }
    }
};
struct EpiKV {
    static constexpr bool PERM = true; static constexpr bool PERMA = false;
    f16_t* KM; f16_t* VM; const float* ss_in; const float* gkm;
    __device__ __forceinline__ void prefetch(const Unit&, const Order&, LAS unsigned char*, int, int, int) const {}
    __device__ __forceinline__ void operator()(f32x4 (&acc)[2][2][4][2], const Unit& u, const Order& S, int wr, int wc, int fr_, int fq_, LAS unsigned char*, int) const {
        int fr = fr_, fq = fq_; asm volatile("" : "+v"(fr), "+v"(fq));
        const bool isk = (u.pn == 0);
        f16_t* dst = (isk ? KM : VM) + (size_t)(u.pm * 4 + wc) * NMEM * HD;
        f32x4 gv[2][2];
#pragma unroll
        for (int bj = 0; bj < 2; ++bj)
#pragma unroll
            for (int n = 0; n < 2; ++n) gv[bj][n] = isk ? *(const f32x4*)(gkm + 32 * bj + 8 * fq + 4 * n) : (f32x4){1.f, 1.f, 1.f, 1.f};
#pragma unroll
        for (int ai = 0; ai < 2; ++ai)
#pragma unroll
            for (int m = 0; m < 4; ++m) {
                const int key = ai * HALF + wr * 64 + m * 16 + fr;
                const float sc = __builtin_amdgcn_rsqf(ss_in[u.pm * BM + key] * (1.0f / DM) + EPS);
                f32x4 v[2][2]; float sq = 0.f;
#pragma unroll
                for (int bj = 0; bj < 2; ++bj)
#pragma unroll
                    for (int n = 0; n < 2; ++n) { v[bj][n] = acc[ai][bj][m][n] * sc; const f32x4 t = v[bj][n]; sq += (t[0] * t[0] + t[1] * t[1]) + (t[2] * t[2] + t[3] * t[3]); }
                float rn = 1.f;
                if (isk) { sq += __shfl_xor(sq, 16); sq += __shfl_xor(sq, 32); rn = __builtin_amdgcn_rsqf(sq * (1.0f / HD) + EPS); }
#pragma unroll
                for (int bj = 0; bj < 2; ++bj) {
                    const f32x4 a = v[bj][0] * rn * gv[bj][0], b = v[bj][1] * rn * gv[bj][1];
                    u32x4 w; w.x = pkh(a[0], a[1]); w.y = pkh(a[2], a[3]); w.z = pkh(b[0], b[1]); w.w = pkh(b[2], b[3]);
                    *(u32x4*)(dst + (size_t)key * HD + 32 * bj + 8 * fq) = w;
                }
            }
    }
};
struct EpiNull {
    static constexpr bool PERM = true; static constexpr bool PERMA = false;
    __device__ __forceinline__ void prefetch(const Unit&, const Order&, LAS unsigned char*, int, int, int) const {}
    __device__ __forceinline__ void operator()(f32x4 (&acc)[2][2][4][2], const Unit& u, const Order& S, int wr, int wc, int fr_, int fq_, LAS unsigned char*, int) const {
#pragma unroll
        for (int ai = 0; ai < 2; ++ai)
#pragma unroll
            for (int bj = 0; bj < 2; ++bj)
#pragma unroll
                for (int m = 0; m < 4; ++m)
#pragma unroll
                    for (int n = 0; n < 2; ++n) asm volatile("" :: "v"(acc[ai][bj][m][n]));
    }
};
}

#define XB_TMO      128
#define XB_XCNT(j)  (256  + 64 * (j))
#define XB_XSUB(j)  (1280 + 64 * (j))
#define XB_XGEN(j)  (2304 + 64 * (j))
#define XB_TOP      3328
#define XB_TOPGEN   3392
#define XCD_BAR_WORDS 3456
#define XB_SPIN_CAP (1u << 18)
__device__ __forceinline__ unsigned xb_ld(unsigned* p)              { return __hip_atomic_load(p, __ATOMIC_RELAXED, __HIP_MEMORY_SCOPE_AGENT); }
__device__ __forceinline__ unsigned xb_add(unsigned* p, unsigned v) { return __hip_atomic_fetch_add(p, v, __ATOMIC_RELAXED, __HIP_MEMORY_SCOPE_AGENT); }
__device__ __forceinline__ unsigned xb_xcc_id() { return (unsigned)__builtin_amdgcn_s_getreg((3 << 11) | 20) & 0xFu; }
#define XB_SPIN(cond, bar) do { unsigned _sp = 0; while (cond) { __builtin_amdgcn_s_sleep(1); \
    if ((++_sp & 255u) == 0u) { if (xb_ld(&(bar)[XB_TMO])) break; if (_sp > XB_SPIN_CAP) { atomicAdd(&(bar)[XB_TMO], 1u); break; } } } } while (0)
struct XcdBarrier { unsigned* bar; unsigned x; volatile LAS unsigned* st; };
__device__ __forceinline__ XcdBarrier xcd_barrier_post(unsigned* bar, volatile LAS unsigned* st) {
    XcdBarrier b; b.bar = bar; b.x = xb_xcc_id(); b.st = st;
    if (threadIdx.x == 0) (void)xb_add(&bar[XB_XCNT(b.x)], 1u);
    return b;
}
__device__ __forceinline__ void xcd_barrier_complete(unsigned* bar, unsigned x, unsigned& nloc, unsigned& nx) {
    const unsigned G = gridDim.x * gridDim.y * gridDim.z;
    unsigned sum, cnt, mine, sp = 0u;
    for (;;) {
        sum = 0u; cnt = 0u; mine = 0u;
#pragma unroll
        for (unsigned j = 0; j < 16; ++j) { const unsigned c = xb_ld(&bar[XB_XCNT(j)]); sum += c; cnt += (c > 0u) ? 1u : 0u; mine = (j == x) ? c : mine; }
        if (sum == G) break;
        __builtin_amdgcn_s_sleep(1);
        if ((++sp & 255u) == 0u) { if (xb_ld(&bar[XB_TMO])) break; if (sp > XB_SPIN_CAP) { atomicAdd(&bar[XB_TMO], 1u); break; } }
    }
    nloc = mine > 0u ? mine : 1u; nx = cnt > 0u ? cnt : 1u;
}
__device__ __forceinline__ void xcd_barrier(const XcdBarrier& b) {
    asm volatile("s_waitcnt vmcnt(0)" ::: "memory");
    __syncthreads();
    if (threadIdx.x == 0) {
        unsigned* bar = b.bar;
        __builtin_amdgcn_s_waitcnt(0);
        unsigned nloc = b.st[0], nx = b.st[1];
        if (nloc == 0u) { xcd_barrier_complete(bar, b.x, nloc, nx); b.st[0] = nloc; b.st[1] = nx; }
        const unsigned old = xb_add(&bar[XB_XSUB(b.x)], 1u);
        const unsigned gen = old / nloc;
        if (old + 1u == (gen + 1u) * nloc) {
            __builtin_amdgcn_fence(__ATOMIC_RELEASE, "agent");
            asm volatile("s_waitcnt vmcnt(0)" ::: "memory");
            unsigned og;
            { unsigned* tp = &bar[XB_TOP]; const unsigned one = 1u;
              asm volatile("global_atomic_add %0, %1, %2, off sc0\n\tbuffer_inv sc1\n\ts_waitcnt vmcnt(0)" : "=&v"(og) : "v"(tp), "v"(one) : "memory"); }
            const unsigned tg = og / nx;
            if (og + 1u == (tg + 1u) * nx) xb_add(&bar[XB_TOPGEN], 1u);
            else XB_SPIN(xb_ld(&bar[XB_TOPGEN]) == tg, bar);
            asm volatile("s_waitcnt vmcnt(0)" ::: "memory");
            xb_add(&bar[XB_XGEN(b.x)], 1u);
            asm volatile("s_waitcnt vmcnt(0)" ::: "memory");
        } else {
            XB_SPIN(xb_ld(&bar[XB_XGEN(b.x)]) == gen, bar);
            asm volatile("buffer_inv sc0\n\ts_waitcnt vmcnt(0)" ::: "memory");
        }
    }
    __syncthreads();
}

struct Args { const float* in[21]; float* out; unsigned char* ws; int ph_lo, ph_hi; };
struct Frame {
    LAS unsigned char* lds; volatile LAS unsigned* MISC; gu32* ctl;
    int tid, lane, wave, vcu, G;
};

template <bool FP8>
__device__ __forceinline__ void p0_transpose_item(const float* W, int K, int N, f16_t* WT, const float* gain, LAS float* scr, int k0, int n0, int dst0, int lane) {
    { f32x4 v[8];
#pragma unroll
        for (int i = 0; i < 8; ++i) v[i] = __builtin_nontemporal_load((const f32x4*)(W + (size_t)(k0 + (lane >> 3) + 8 * i) * N + n0 + 4 * (lane & 7)));
#pragma unroll
        for (int i = 0; i < 8; ++i) { const int kk = (lane >> 3) + 8 * i; const float gsc = (gain ? gain[k0 + kk] : 1.0f) * (FP8 ? F8_SW : 1.0f);
#pragma unroll
            for (int e = 0; e < 4; ++e) scr[kk * 33 + 4 * (lane & 7) + e] = v[i][e] * gsc; } }
    LDS_WAIT(); asm volatile("" ::: "memory");
    const int c = lane & 7;
#pragma unroll
    for (int j = 0; j < 4; ++j) { const int n = (lane >> 3) + 8 * j; const LAS float* s = scr + (8 * c) * 33 + n;
        if constexpr (FP8) { u32x2 o; o.x = pk8(s[0 * 33], s[1 * 33], s[2 * 33], s[3 * 33]); o.y = pk8(s[4 * 33], s[5 * 33], s[6 * 33], s[7 * 33]);
            *(GAS u32x2*)((unsigned char*)WT + (size_t)(dst0 + n) * K + k0 + 8 * c) = o; }
        else { u32x4 o; o.x = pkh(s[0 * 33], s[1 * 33]); o.y = pkh(s[2 * 33], s[3 * 33]); o.z = pkh(s[4 * 33], s[5 * 33]); o.w = pkh(s[6 * 33], s[7 * 33]);
            *(GAS u32x4*)(WT + (size_t)(dst0 + n) * K + k0 + 8 * c) = o; } }
    LDS_WAIT(); asm volatile("" ::: "memory");
}
__device__ __forceinline__ int map_ident(int n0) { return n0; }
__device__ __forceinline__ int map_heads(int n0) { const int t = n0 >> 8, l = n0 & 255, wc = l >> 6, bj = (l >> 5) & 1; return (t << 8) + 128 * bj + 32 * wc; }
__device__ __forceinline__ int map_up(int n0) { const int bj = n0 >= FF ? 1 : 0, j = n0 - bj * FF; return 256 * (j >> 7) + 128 * bj + (j & 127); }

template <int MAP, bool FP8 = false>
__device__ __forceinline__ void p0_matrix(const Frame& F, const float* W, int K, int N, f16_t* WT, const float* gain, int& base, int gw, int NGW, LAS float* scr) {
    const int nblk = N / 32, items = (K / 64) * nblk;
    int first = gw - (base % NGW); if (first < 0) first += NGW;
    for (int it = first; it < items; it += NGW) {
        const int kb = it / nblk, nb = it % nblk, n0 = 32 * nb;
        const int d0 = (MAP == 0) ? map_ident(n0) : (MAP == 1) ? map_heads(n0) : map_up(n0);
        p0_transpose_item<FP8>(W, K, N, WT, gain, scr, 64 * kb, n0, d0, F.lane);
    }
    base += items;
}

__device__ __forceinline__ void p0_late_weights(const Frame& F, const Args& a, int gw, int NGW) {
    unsigned char* ws = a.ws;
    LAS float* scr = (LAS float*)(F.lds + F.wave * 16384);
    int base = 0;
    p0_matrix<0>(F, a.in[5], DM, DM, (f16_t*)(ws + WS_WOUTA), nullptr, base, gw, NGW, scr);
    p0_matrix<2>(F, a.in[17], DM, FF2, (f16_t*)(ws + WS_WUP0), a.in[3], base, gw, NGW, scr);
    p0_matrix<0>(F, a.in[20], FF, DM, (f16_t*)(ws + WS_WDN0), nullptr, base, gw, NGW, scr);
}
__device__ __forceinline__ void p0_prologue(const Frame& F, const Args& a) {
    unsigned char* ws = a.ws;
    LAS float* scr = (LAS float*)(F.lds + F.wave * 16384);
    const int gw = F.vcu * NWAVES + F.wave, NGW = F.G * NWAVES;
    int base = 0;
    p0_matrix<0>(F, a.in[4], DM, NA, (f16_t*)(ws + WS_WINA), a.in[2], base, gw, NGW, scr);
    p0_matrix<1, true>(F, a.in[9], DM, NB, (f16_t*)(ws + WS_WINB), a.in[2] + DM, base, gw, NGW, scr);
    p0_matrix<0, true>(F, a.in[10], DM, DM, (f16_t*)(ws + WS_WOUTB), nullptr, base, gw, NGW, scr);
    p0_matrix<2>(F, a.in[17] + (size_t)DM * FF2, DM, FF2, (f16_t*)(ws + WS_WUP1), a.in[3] + DM, base, gw, NGW, scr);
    p0_matrix<0>(F, a.in[20] + (size_t)FF * DM, FF, DM, (f16_t*)(ws + WS_WDN1), nullptr, base, gw, NGW, scr);
    p0_matrix<1>(F, a.in[14], DM, 2 * MEMW, (f16_t*)(ws + WS_WKV), a.in[13], base, gw, NGW, scr);
    for (int ci = F.vcu * 512 + F.tid; ci < NGRP * CHUNK * 16; ci += F.G * 512) { const int g = ci / (CHUNK * 16), t = (ci >> 4) & (CHUNK - 1), c = ci & 15;
        const float* src = a.in[7] + (size_t)g * CHUNK * CHUNK + t * CHUNK + 8 * c; u32x4 o = {0u, 0u, 0u, 0u};
        if (8 * c <= t) { const f32x4 x0 = *(const f32x4*)src, x1 = *(const f32x4*)(src + 4); float v[8] = {x0[0], x0[1], x0[2], x0[3], x1[0], x1[1], x1[2], x1[3]};
#pragma unroll
            for (int j = 0; j < 8; ++j) v[j] = (8 * c + j <= t) ? v[j] : 0.f;
            o.x = pkh(v[0], v[1]); o.y = pkh(v[2], v[3]); o.z = pkh(v[4], v[5]); o.w = pkh(v[6], v[7]); }
        *(u32x4*)(ws + WS_W16S + (size_t)g * 32768 + t * 256 + ((c ^ (t & 15)) << 4)) = o; }
    {
        const float* x = a.in[0]; f16_t* A16 = (f16_t*)(ws + WS_A16); float* ss0 = (float*)(F.ctl + CW_SS0);
        for (int m0 = gw; m0 < M; m0 += 4 * NGW) {
            f32x4 v[4][4];
#pragma unroll
            for (int r = 0; r < 4; ++r) { const int mm = (m0 + r * NGW < M) ? m0 + r * NGW : m0; const GAS f32x4* xr = (const GAS f32x4*)(x + (size_t)mm * DM) + F.lane;
#pragma unroll
                for (int j = 0; j < 4; ++j) v[r][j] = __builtin_nontemporal_load(xr + 64 * j); }
#pragma unroll
            for (int r = 0; r < 4; ++r) { const int m = m0 + r * NGW; if (m >= M) break; float s = 0.f;
#pragma unroll
                for (int j = 0; j < 4; ++j) s += (v[r][j].x * v[r][j].x + v[r][j].y * v[r][j].y) + (v[r][j].z * v[r][j].z + v[r][j].w * v[r][j].w);
                s = wave_sum(s);
                if (F.lane == 0) ss0[m] = s;
                GAS u32x2* o8 = (GAS u32x2*)(A16 + (size_t)m * DM) + F.lane;
#pragma unroll
                for (int j = 0; j < 4; ++j) { u32x2 w; w.x = pkh(v[r][j].x, v[r][j].y); w.y = pkh(v[r][j].z, v[r][j].w); o8[64 * j] = w; } }
        }
    }
    {
        const float* x = a.in[1]; f16_t* X16 = (f16_t*)(ws + WS_MEM16); float* ssm = (float*)(F.ctl + CW_SSM);
        for (int m = gw; m < BATCH * NMEM; m += NGW) {
            const GAS f32x4* xr = (const GAS f32x4*)(x + (size_t)m * DM) + F.lane;
            f32x4 v[4]; float s = 0.f;
#pragma unroll
            for (int j = 0; j < 4; ++j) { v[j] = xr[64 * j]; s += (v[j].x * v[j].x + v[j].y * v[j].y) + (v[j].z * v[j].z + v[j].w * v[j].w); }
            s = wave_sum(s);
            if (F.lane == 0) ssm[m] = s;
            GAS u32x2* o8 = (GAS u32x2*)(X16 + (size_t)m * DM) + F.lane;
#pragma unroll
            for (int j = 0; j < 4; ++j) { u32x2 w; w.x = pkh(v[j].x, v[j].y); w.y = pkh(v[j].z, v[j].w); o8[64 * j] = w; }
        }
    }
}

typedef short v4i16_t __attribute__((ext_vector_type(4)));
__device__ __forceinline__ h16x4 vtr(LAS const unsigned char* p) { return __builtin_bit_cast(h16x4, __builtin_amdgcn_ds_read_tr16_b64_v4i16((LAS v4i16_t*)p)); }
__device__ __forceinline__ h16x8 cat8(h16x4 lo, h16x4 hi) { return (h16x8){lo[0], lo[1], lo[2], lo[3], hi[0], hi[1], hi[2], hi[3]}; }
__device__ __forceinline__ u32x4 pair16(u32x2 a, u32x2 b) {
    const auto r0 = __builtin_amdgcn_permlane16_swap(a.x, b.x, false, false), r1 = __builtin_amdgcn_permlane16_swap(a.y, b.y, false, false);
    return (u32x4){r0[0], r1[0], r0[1], r1[1]};
}
__device__ __forceinline__ void unpair16(u32x4 v, u32x2& a, u32x2& b) {
    const auto r0 = __builtin_amdgcn_permlane16_swap(v.x, v.z, false, false), r1 = __builtin_amdgcn_permlane16_swap(v.y, v.w, false, false);
    a = (u32x2){r0[0], r1[0]}; b = (u32x2){r0[1], r1[1]};
}
__device__ __forceinline__ int pair16_dim(int G, int dt0) { return (G & 1) ? 16 * (dt0 + 1) + 4 * (G - 1) : 16 * dt0 + 4 * G; }
__device__ __forceinline__ void store_o16(f16_t* rowp, const f32x4 (&o)[4], float il, int G) {
#pragma unroll
    for (int pr = 0; pr < 2; ++pr) { const int dt0 = 2 * pr;
        u32x2 a, b; a.x = pkh(o[dt0][0] * il, o[dt0][1] * il); a.y = pkh(o[dt0][2] * il, o[dt0][3] * il); b.x = pkh(o[dt0 + 1][0] * il, o[dt0 + 1][1] * il); b.y = pkh(o[dt0 + 1][2] * il, o[dt0 + 1][3] * il);
        *(u32x4*)(rowp + pair16_dim(G, dt0)) = pair16(a, b); }
}
__device__ __forceinline__ void store_o8(unsigned char* rowp, const f32x4 (&o)[4], float il, int G) {
    const float c = il * F8_SY;
#pragma unroll
    for (int pr = 0; pr < 2; ++pr) { const int dt0 = 2 * pr;
        const unsigned a = pk8(o[dt0][0] * c, o[dt0][1] * c, o[dt0][2] * c, o[dt0][3] * c), b = pk8(o[dt0 + 1][0] * c, o[dt0 + 1][1] * c, o[dt0 + 1][2] * c, o[dt0 + 1][3] * c);
        const auto r = __builtin_amdgcn_permlane16_swap(a, b, false, false);
        *(u32x2*)(rowp + pair16_dim(G, dt0)) = (u32x2){r[0], r[1]}; }
}
constexpr float LOG2E = 1.4426950408889634f;
constexpr float BOUND_SHIFT = 4.0f;

__device__ __forceinline__ void stage_k_img(LAS unsigned char* img, const f16_t* src, int pitch, int nrows, int tid) {
    for (int ci = tid; ci < nrows * 8; ci += 512) { const int r = ci >> 3, c = ci & 7;
        const u32x4 v = *(const u32x4*)(src + (size_t)r * pitch + 8 * c);
        *(LAS u32x4*)(img + r * 128 + ((c ^ (r & 7)) << 4)) = v; }
}
__device__ __forceinline__ void stage_v_img(LAS unsigned char* img, const f16_t* src, int pitch, int nrows, int tid) {
    for (int ci = tid; ci < nrows * 8; ci += 512) { const int r = ci >> 3, c = ci & 7;
        const u32x4 v = *(const u32x4*)(src + (size_t)r * pitch + 8 * c);
        *(LAS u32x4*)(img + r * 128 + ((((c >> 1) ^ ((r >> 1) & 3))) << 5) + ((c & 1) << 4)) = v; }
}
__device__ __forceinline__ void glds16_asm(const void* gsrc, unsigned lds_dst) { unsigned keep;
    asm volatile("s_mov_b32 %0, m0\n\ts_mov_b32 m0, %2\n\ts_nop 0\n\tglobal_load_lds_dwordx4 %1, off\n\ts_mov_b32 m0, %0" : "=&s"(keep) : "v"(gsrc), "s"(lds_dst) : "memory"); }
__device__ __forceinline__ void dma_kv_imgs(LAS unsigned char* Kimg, LAS unsigned char* Vimg, const f16_t* ksrc, const f16_t* vsrc, int wave, int lane, int pitch = NB) {
    const int rl = lane >> 3, pos = lane & 7;
    const int kc = pos ^ rl, vc = 2 * ((pos >> 1) ^ ((lane >> 4) & 3)) + (pos & 1);
    const unsigned kd = (unsigned)__builtin_amdgcn_readfirstlane((int)(unsigned)(uintptr_t)Kimg), vd = (unsigned)__builtin_amdgcn_readfirstlane((int)(unsigned)(uintptr_t)Vimg);
#pragma unroll
    for (int i = 0; i < 4; ++i) { const int pc = wave + 8 * i, row = 8 * pc + rl;
        glds16_asm(ksrc + (size_t)row * pitch + 8 * kc, (unsigned)__builtin_amdgcn_readfirstlane((int)(kd + pc * 1024)));
        glds16_asm(vsrc + (size_t)row * pitch + 8 * vc, (unsigned)__builtin_amdgcn_readfirstlane((int)(vd + pc * 1024))); }
}
template <bool CAUSAL>
__device__ __forceinline__ void attn_tile(LAS const unsigned char* Kimg, LAS const unsigned char* Vimg, int nsteps, h16x8 q0, h16x8 q1, float mb, int qrel, f32x4 (&o)[4], float& lsum, int lane) {
    const int fr = lane & 15, G = lane >> 4, qq = fr >> 2, p = fr & 3;
    const int kof0 = fr * 128 + (((0 + G) ^ (fr & 7)) << 4), kof1 = fr * 128 + (((4 + G) ^ (fr & 7)) << 4);
    const int vrow = (4 * G + qq) * 128 + p * 8, sw = (2 * G + (qq >> 1)) & 3;
    for (int ks = 0; ks < nsteps; ++ks) {
        LAS const unsigned char* kb = Kimg + ks * 4096;
        const h16x8 a00 = *(LAS const h16x8*)(kb + kof0), a01 = *(LAS const h16x8*)(kb + kof1);
        const h16x8 a10 = *(LAS const h16x8*)(kb + 2048 + kof0), a11 = *(LAS const h16x8*)(kb + 2048 + kof1);
        f32x4 s0 = {0.f, 0.f, 0.f, 0.f}, s1 = {0.f, 0.f, 0.f, 0.f};
        s0 = __builtin_amdgcn_mfma_f32_16x16x32_f16(a00, q0, s0, 0, 0, 0); s0 = __builtin_amdgcn_mfma_f32_16x16x32_f16(a01, q1, s0, 0, 0, 0);
        s1 = __builtin_amdgcn_mfma_f32_16x16x32_f16(a10, q0, s1, 0, 0, 0); s1 = __builtin_amdgcn_mfma_f32_16x16x32_f16(a11, q1, s1, 0, 0, 0);
        f32x4 p0, p1;
#pragma unroll
        for (int e = 0; e < 4; ++e) { p0[e] = __builtin_amdgcn_exp2f(s0[e] - mb); p1[e] = __builtin_amdgcn_exp2f(s1[e] - mb); }
        if (CAUSAL) { const int kr = ks * 32 + 4 * G;
#pragma unroll
            for (int e = 0; e < 4; ++e) { if (kr + e > qrel) p0[e] = 0.f; if (kr + 16 + e > qrel) p1[e] = 0.f; } }
        lsum += ((p0[0] + p0[1]) + (p0[2] + p0[3])) + ((p1[0] + p1[1]) + (p1[2] + p1[3]));
        u32x4 pw; pw.x = pkh(p0[0], p0[1]); pw.y = pkh(p0[2], p0[3]); pw.z = pkh(p1[0], p1[1]); pw.w = pkh(p1[2], p1[3]);
        const h16x8 pf = __builtin_bit_cast(h16x8, pw);
        LAS const unsigned char* vb = Vimg + ks * 4096 + vrow;
#pragma unroll
        for (int dt = 0; dt < 4; ++dt) {
            const h16x4 lo = vtr(vb + ((dt ^ sw) << 5)), hi = vtr(vb + 2048 + ((dt ^ sw) << 5));
            o[dt] = __builtin_amdgcn_mfma_f32_16x16x32_f16(cat8(lo, hi), pf, o[dt], 0, 0, 0);
        }
    }
}
template <bool CAUSAL, bool SHARED>
__device__ __forceinline__ void attn_tile2(LAS const unsigned char* Ka, LAS const unsigned char* Va, LAS const unsigned char* Kb, LAS const unsigned char* Vb, int nsteps,
                                           h16x8 qa0, h16x8 qa1, float mba, int qrela, h16x8 qb0, h16x8 qb1, float mbb, int qrelb,
                                           f32x4 (&oa)[4], f32x4 (&ob)[4], float& lsa_out, float& lsb_out, int lane) {
    const int fr = lane & 15, G = lane >> 4, qq = fr >> 2, p = fr & 3;
    const int kof0 = fr * 128 + (((0 + G) ^ (fr & 7)) << 4), kof1 = fr * 128 + (((4 + G) ^ (fr & 7)) << 4);
    const int vrow = (4 * G + qq) * 128 + p * 8, sw = (2 * G + (qq >> 1)) & 3;
    const h16x8 ones = {(_Float16)1.0f, (_Float16)1.0f, (_Float16)1.0f, (_Float16)1.0f, (_Float16)1.0f, (_Float16)1.0f, (_Float16)1.0f, (_Float16)1.0f};
    const f32x4 nma = {-mba, -mba, -mba, -mba}, nmb = {-mbb, -mbb, -mbb, -mbb};
    f32x4 la = {0.f, 0.f, 0.f, 0.f}, lb = la;
    h16x8 ka[4], kb[4];
    ka[0] = *(LAS const h16x8*)(Ka + kof0); ka[1] = *(LAS const h16x8*)(Ka + kof1); ka[2] = *(LAS const h16x8*)(Ka + 2048 + kof0); ka[3] = *(LAS const h16x8*)(Ka + 2048 + kof1);
    if (!SHARED) { kb[0] = *(LAS const h16x8*)(Kb + kof0); kb[1] = *(LAS const h16x8*)(Kb + kof1); kb[2] = *(LAS const h16x8*)(Kb + 2048 + kof0); kb[3] = *(LAS const h16x8*)(Kb + 2048 + kof1); }
    for (int ks = 0; ks < nsteps; ++ks) {
        LAS const unsigned char* va = Va + ks * 4096 + vrow; LAS const unsigned char* vb = Vb + ks * 4096 + vrow;
        h16x4 fal[4], fah[4], fbl[4], fbh[4];
#pragma unroll
        for (int dt = 0; dt < 4; ++dt) { fal[dt] = vtr(va + ((dt ^ sw) << 5)); fah[dt] = vtr(va + 2048 + ((dt ^ sw) << 5));
            if (!SHARED) { fbl[dt] = vtr(vb + ((dt ^ sw) << 5)); fbh[dt] = vtr(vb + 2048 + ((dt ^ sw) << 5)); } }
        __builtin_amdgcn_sched_barrier(0);
        f32x4 sa0, sa1, sb0, sb1;
        sa0 = __builtin_amdgcn_mfma_f32_16x16x32_f16(ka[0], qa0, nma, 0, 0, 0); sb0 = __builtin_amdgcn_mfma_f32_16x16x32_f16(SHARED ? ka[0] : kb[0], qb0, nmb, 0, 0, 0);
        sa1 = __builtin_amdgcn_mfma_f32_16x16x32_f16(ka[2], qa0, nma, 0, 0, 0); sb1 = __builtin_amdgcn_mfma_f32_16x16x32_f16(SHARED ? ka[2] : kb[2], qb0, nmb, 0, 0, 0);
        sa0 = __builtin_amdgcn_mfma_f32_16x16x32_f16(ka[1], qa1, sa0, 0, 0, 0); sb0 = __builtin_amdgcn_mfma_f32_16x16x32_f16(SHARED ? ka[1] : kb[1], qb1, sb0, 0, 0, 0);
        sa1 = __builtin_amdgcn_mfma_f32_16x16x32_f16(ka[3], qa1, sa1, 0, 0, 0); sb1 = __builtin_amdgcn_mfma_f32_16x16x32_f16(SHARED ? ka[3] : kb[3], qb1, sb1, 0, 0, 0);
        __builtin_amdgcn_sched_barrier(0);
        if (ks + 1 < nsteps) { LAS const unsigned char* kn = Ka + (ks + 1) * 4096;
            ka[0] = *(LAS const h16x8*)(kn + kof0); ka[1] = *(LAS const h16x8*)(kn + kof1); ka[2] = *(LAS const h16x8*)(kn + 2048 + kof0); ka[3] = *(LAS const h16x8*)(kn + 2048 + kof1);
            if (!SHARED) { LAS const unsigned char* kn2 = Kb + (ks + 1) * 4096;
                kb[0] = *(LAS const h16x8*)(kn2 + kof0); kb[1] = *(LAS const h16x8*)(kn2 + kof1); kb[2] = *(LAS const h16x8*)(kn2 + 2048 + kof0); kb[3] = *(LAS const h16x8*)(kn2 + 2048 + kof1); } }
        __builtin_amdgcn_sched_barrier(0);
        f32x4 pa0, pa1, pb0, pb1;
#pragma unroll
        for (int e = 0; e < 4; ++e) { pa0[e] = __builtin_amdgcn_exp2f(sa0[e]); pa1[e] = __builtin_amdgcn_exp2f(sa1[e]);
                                      pb0[e] = __builtin_amdgcn_exp2f(sb0[e]); pb1[e] = __builtin_amdgcn_exp2f(sb1[e]); }
        if (CAUSAL) { const int kr = ks * 32 + 4 * G;
#pragma unroll
            for (int e = 0; e < 4; ++e) { if (kr + e > qrela) pa0[e] = 0.f; if (kr + 16 + e > qrela) pa1[e] = 0.f; if (kr + e > qrelb) pb0[e] = 0.f; if (kr + 16 + e > qrelb) pb1[e] = 0.f; } }
        u32x4 wa, wb; wa.x = pkh(pa0[0], pa0[1]); wa.y = pkh(pa0[2], pa0[3]); wa.z = pkh(pa1[0], pa1[1]); wa.w = pkh(pa1[2], pa1[3]);
        wb.x = pkh(pb0[0], pb0[1]); wb.y = pkh(pb0[2], pb0[3]); wb.z = pkh(pb1[0], pb1[1]); wb.w = pkh(pb1[2], pb1[3]);
        const h16x8 pfa = __builtin_bit_cast(h16x8, wa), pfb = __builtin_bit_cast(h16x8, wb);
        la = __builtin_amdgcn_mfma_f32_16x16x32_f16(ones, pfa, la, 0, 0, 0); lb = __builtin_amdgcn_mfma_f32_16x16x32_f16(ones, pfb, lb, 0, 0, 0);
#pragma unroll
        for (int dt = 0; dt < 4; ++dt) {
            const h16x8 fa = cat8(fal[dt], fah[dt]);
            const h16x8 fb = SHARED ? fa : cat8(fbl[dt], fbh[dt]);
            oa[dt] = __builtin_amdgcn_mfma_f32_16x16x32_f16(fa, pfa, oa[dt], 0, 0, 0);
            ob[dt] = __builtin_amdgcn_mfma_f32_16x16x32_f16(fb, pfb, ob[dt], 0, 0, 0);
        }
    }
    lsa_out = la[0]; lsb_out = lb[0];
}
__device__ __forceinline__ float wave_max(float v) {
#pragma unroll
    for (int o = 1; o < 64; o <<= 1) v = fmaxf(v, __shfl_xor(v, o));
    return v;
}
__device__ __forceinline__ void xattn_load_q(const f16_t* qp  , const float* gqm, int G, float maxgk, h16x8& q0, h16x8& q1, float& mb) {
    const h16x8 r0v = *(const h16x8*)qp, r1v = *(const h16x8*)(qp + 32);
    float q[16], ss = 0.f;
#pragma unroll
    for (int j = 0; j < 8; ++j) { q[j] = (float)r0v[j]; q[8 + j] = (float)r1v[j]; ss += q[j] * q[j] + q[8 + j] * q[8 + j]; }
    ss += __shfl_xor(ss, 16); ss += __shfl_xor(ss, 32);
    const float rn = 1.0f / sqrtf(ss * (1.0f / HD) + EPS);
    float n2 = 0.f;
#pragma unroll
    for (int j = 0; j < 8; ++j) { q[j] *= rn * gqm[8 * G + j]; q[8 + j] *= rn * gqm[32 + 8 * G + j]; n2 += q[j] * q[j] + q[8 + j] * q[8 + j]; }
    n2 += __shfl_xor(n2, 16); n2 += __shfl_xor(n2, 32);
    mb = (sqrtf(n2) * maxgk - BOUND_SHIFT) * LOG2E;
    const float c = 0.125f * LOG2E;
    u32x4 w0, w1;
    w0.x = pkh(q[0] * c, q[1] * c); w0.y = pkh(q[2] * c, q[3] * c); w0.z = pkh(q[4] * c, q[5] * c); w0.w = pkh(q[6] * c, q[7] * c);
    w1.x = pkh(q[8] * c, q[9] * c); w1.y = pkh(q[10] * c, q[11] * c); w1.z = pkh(q[12] * c, q[13] * c); w1.w = pkh(q[14] * c, q[15] * c);
    q0 = __builtin_bit_cast(h16x8, w0); q1 = __builtin_bit_cast(h16x8, w1);
}
template <bool Y8>
__device__ __forceinline__ void xattn_chunk(const Frame& F, const Args& a, int chunk, const f16_t* P, int ldp, int qcol0, const float* gqm, f16_t* Y) {
    const float* gkm = a.in[15];
    const f16_t* KM = (const f16_t*)(a.ws + WS_KM16); const f16_t* VM = (const f16_t*)(a.ws + WS_VM16);
    const int r0 = chunk * CHUNK, b = r0 / SEQ, lane = F.lane, fr = lane & 15, G = lane >> 4;
    const float maxgk = wave_max(fabsf(gkm[lane]));
    const int hsel = F.wave >> 2, rowa = r0 + 32 * (F.wave & 3) + fr, rowb = rowa + 16;
    for (int hp = 0; hp < 2; ++hp) {
#pragma unroll
        for (int k = 0; k < 2; ++k) dma_kv_imgs(F.lds + k * 65536, F.lds + k * 65536 + 32768, KM + (size_t)(b * 4 + 2 * hp + k) * NMEM * HD, VM + (size_t)(b * 4 + 2 * hp + k) * NMEM * HD, F.wave, lane, HD);
        const int head = 2 * hp + hsel;
        h16x8 qa0, qa1, qb0, qb1; float mba, mbb;
        xattn_load_q(P + (size_t)rowa * ldp + qcol0 + head * HD + 8 * G, gqm, G, maxgk, qa0, qa1, mba);
        xattn_load_q(P + (size_t)rowb * ldp + qcol0 + head * HD + 8 * G, gqm, G, maxgk, qb0, qb1, mbb);
        VM_WAIT();
        __syncthreads();
        f32x4 oa[4], ob[4]; float lsa = 0.f, lsb = 0.f;
#pragma unroll
        for (int dt = 0; dt < 4; ++dt) { oa[dt] = (f32x4){0.f, 0.f, 0.f, 0.f}; ob[dt] = oa[dt]; }
        LAS const unsigned char* img = F.lds + hsel * 65536;
        attn_tile2<false, true>(img, img + 32768, img, img + 32768, NMEM / 32, qa0, qa1, mba, 0, qb0, qb1, mbb, 0, oa, ob, lsa, lsb, lane);
        const float ila = 1.0f / lsa, ilb = 1.0f / lsb;
        if constexpr (Y8) { unsigned char* yp = (unsigned char*)Y + MIXW + head * HD; store_o8(yp + (size_t)rowa * DM, oa, ila, G); store_o8(yp + (size_t)rowb * DM, ob, ilb, G); }
        else { f16_t* yp = Y + MIXW + head * HD; store_o16(yp + (size_t)rowa * DM, oa, ila, G); store_o16(yp + (size_t)rowb * DM, ob, ilb, G); }
        __syncthreads();
    }
}

template <bool DO_SGU, bool DO_X>
__device__ __forceinline__ void mixer_a(const Frame& F, const Args& a) {
    const f16_t* P = (const f16_t*)(a.ws + WS_P16); f16_t* Y = (f16_t*)(a.ws + WS_Y16);
    const float* ssv = (const float*)(F.ctl + CW_SSV); const float* gsgu = a.in[6]; const float* wsp = a.in[7]; const float* bsp = a.in[8];
    LAS float* rv = (LAS float*)(F.lds + XCH_OFF);
    const int lane = F.lane, fr = lane & 15, G = lane >> 4, qq = fr >> 2, p = fr & 3, w = F.wave;
    for (int chunk = F.vcu; chunk < M / CHUNK; chunk += F.G) {
        const int r0 = chunk * CHUNK;
        if (F.tid < CHUNK) rv[F.tid] = 1.0f / sqrtf(ssv[r0 + F.tid] * (1.0f / MIXW) + EPS);
        __syncthreads();
        h16x8 zvr[4];
        if (DO_SGU) {
#pragma unroll
            for (int k4 = 0; k4 < 4; ++k4) { const int ci = F.tid + 512 * k4, s2 = ci >> 4, c = ci & 15; zvr[k4] = __builtin_nontemporal_load((const h16x8*)(P + (size_t)(r0 + s2) * NA + MIXW + 8 * c)); } }
        for (int g = 0; g < (DO_SGU ? NGRP : 0); ++g) {
            LAS unsigned char* Wimg = F.lds + (g & 1) * 65536; LAS unsigned char* Vimg = Wimg + 32768;
            { const int c = F.tid & 15; const f32x4 g0 = *(const f32x4*)(gsgu + g * 128 + 8 * c), g1 = *(const f32x4*)(gsgu + g * 128 + 8 * c + 4);
#pragma unroll
              for (int k4 = 0; k4 < 4; ++k4) { const int s2 = (F.tid + 512 * k4) >> 4; const h16x8 zv = zvr[k4]; const float rs = rv[s2];
                u32x4 o; o.x = pkh((float)zv[0] * rs * g0[0], (float)zv[1] * rs * g0[1]); o.y = pkh((float)zv[2] * rs * g0[2], (float)zv[3] * rs * g0[3]);
                o.z = pkh((float)zv[4] * rs * g1[0], (float)zv[5] * rs * g1[1]); o.w = pkh((float)zv[6] * rs * g1[2], (float)zv[7] * rs * g1[3]);
                *(LAS u32x4*)(Vimg + s2 * 256 + (((c >> 1) ^ (s2 & 7)) << 5) + ((c & 1) << 4)) = o; } }
            { const unsigned wd = (unsigned)__builtin_amdgcn_readfirstlane((int)(unsigned)(uintptr_t)Wimg);
#pragma unroll
              for (int i = 0; i < 4; ++i) { const int pc = w + 8 * i; glds16_asm(a.ws + WS_W16S + (size_t)g * 32768 + pc * 1024 + lane * 16, (unsigned)__builtin_amdgcn_readfirstlane((int)(wd + pc * 1024))); } }
            const int t = 16 * w + fr, row = r0 + t;
            h16x8 ur[4];
#pragma unroll
            for (int pr = 0; pr < 4; ++pr) ur[pr] = __builtin_nontemporal_load((const h16x8*)(P + (size_t)row * NA + g * 128 + pair16_dim(G, 2 * pr)));
            if (g + 1 < NGRP) {
#pragma unroll
                for (int k4 = 0; k4 < 4; ++k4) { const int ci = F.tid + 512 * k4, s2 = ci >> 4, c = ci & 15; zvr[k4] = __builtin_nontemporal_load((const h16x8*)(P + (size_t)(r0 + s2) * NA + MIXW + (g + 1) * 128 + 8 * c)); }
                asm volatile("s_waitcnt vmcnt(8)" ::: "memory");
            } else asm volatile("s_waitcnt vmcnt(4)" ::: "memory");
            __syncthreads();
            f32x4 acc[8];
#pragma unroll
            for (int dt = 0; dt < 8; ++dt) acc[dt] = (f32x4){0.f, 0.f, 0.f, 0.f};
            const int nsteps = (w >> 1) + 1;
            for (int ks = 0; ks < nsteps; ++ks) {
                const h16x8 bf = *(LAS const h16x8*)(Wimg + (16 * w + fr) * 256 + (((4 * ks + G) ^ fr) << 4));
                LAS const unsigned char* v0 = Vimg + (32 * ks + 8 * G + qq) * 256 + p * 8;
#pragma unroll
                for (int dt = 0; dt < 8; ++dt) {
                    const h16x4 lo = vtr(v0 + ((dt ^ qq) << 5)), hi = vtr(v0 + 4 * 256 + ((dt ^ (4 + qq)) << 5));
                    acc[dt] = __builtin_amdgcn_mfma_f32_16x16x32_f16(cat8(lo, hi), bf, acc[dt], 0, 0, 0);
                }
            }
            const float bias = bsp[g * CHUNK + t];
#pragma unroll
            for (int pr = 0; pr < 4; ++pr) { const int dt0 = 2 * pr, col = g * 128 + pair16_dim(G, dt0);
                u32x2 xa, xb; xa.x = pkh(acc[dt0][0] + bias, acc[dt0][1] + bias); xa.y = pkh(acc[dt0][2] + bias, acc[dt0][3] + bias);
                xb.x = pkh(acc[dt0 + 1][0] + bias, acc[dt0 + 1][1] + bias); xb.y = pkh(acc[dt0 + 1][2] + bias, acc[dt0 + 1][3] + bias);
                const h16x8 m8 = __builtin_bit_cast(h16x8, pair16(xa, xb));
                *(h16x8*)(Y + (size_t)row * DM + col) = ur[pr] * m8; }
        }
        __syncthreads();
        if (DO_X) xattn_chunk<false>(F, a, chunk, P, NA, 2 * MIXW, a.in[16], Y);
    }
}

__device__ __forceinline__ void moba_load_q(const f16_t* qrow, int G, float maxgk, h16x8& q0, h16x8& q1, float& mb) {
    const h16x8 r0v = *(const h16x8*)(qrow + 8 * G), r1v = *(const h16x8*)(qrow + 32 + 8 * G);
    float q[16], n2 = 0.f;
#pragma unroll
    for (int j = 0; j < 8; ++j) { q[j] = (float)r0v[j]; q[8 + j] = (float)r1v[j]; n2 += q[j] * q[j] + q[8 + j] * q[8 + j]; }
    n2 += __shfl_xor(n2, 16); n2 += __shfl_xor(n2, 32);
    mb = (sqrtf(n2) * maxgk - BOUND_SHIFT) * LOG2E;
    const float c = 0.125f * LOG2E;
    u32x4 w0, w1;
    w0.x = pkh(q[0] * c, q[1] * c); w0.y = pkh(q[2] * c, q[3] * c); w0.z = pkh(q[4] * c, q[5] * c); w0.w = pkh(q[6] * c, q[7] * c);
    w1.x = pkh(q[8] * c, q[9] * c); w1.y = pkh(q[10] * c, q[11] * c); w1.z = pkh(q[12] * c, q[13] * c); w1.w = pkh(q[14] * c, q[15] * c);
    q0 = __builtin_bit_cast(h16x8, w0); q1 = __builtin_bit_cast(h16x8, w1);
}
__device__ __forceinline__ void moba_finish_q(h16x8 r0v, h16x8 r1v, float maxgk, h16x8& q0, h16x8& q1, float& mb) {
    float q[16], n2 = 0.f;
#pragma unroll
    for (int j = 0; j < 8; ++j) { q[j] = (float)r0v[j]; q[8 + j] = (float)r1v[j]; n2 += q[j] * q[j] + q[8 + j] * q[8 + j]; }
    n2 += __shfl_xor(n2, 16); n2 += __shfl_xor(n2, 32);
    mb = (sqrtf(n2) * maxgk - BOUND_SHIFT) * LOG2E;
    const float c = 0.125f * LOG2E;
    u32x4 w0, w1;
    w0.x = pkh(q[0] * c, q[1] * c); w0.y = pkh(q[2] * c, q[3] * c); w0.z = pkh(q[4] * c, q[5] * c); w0.w = pkh(q[6] * c, q[7] * c);
    w1.x = pkh(q[8] * c, q[9] * c); w1.y = pkh(q[10] * c, q[11] * c); w1.z = pkh(q[12] * c, q[13] * c); w1.w = pkh(q[14] * c, q[15] * c);
    q0 = __builtin_bit_cast(h16x8, w0); q1 = __builtin_bit_cast(h16x8, w1);
}
constexpr int LIST_CAP = 768, OFFS_LD = 68;

__device__ __forceinline__ unsigned sel_key(float g, int j) {
    const unsigned b = __builtin_bit_cast(unsigned, g);
    const unsigned o = (b & 0x80000000u) ? ~b : (b | 0x80000000u);
    return (o & ~63u) | (unsigned)(63 - j);
}
#define SEL_INSERT(k) do { const unsigned a_ = min(t0, (k)); t0 = max(t0, (k)); const unsigned b_ = min(t1, a_); t1 = max(t1, a_); t2 = max(t2, b_); } while (0)
__device__ __forceinline__ void moba_select(const Frame& F, const Args& a) {
    const f16_t* P = (const f16_t*)(a.ws + WS_P16);
    const float* kmean = (const float*)(F.ctl + CW_KMEAN);
    unsigned short* LIST = (unsigned short*)(a.ws + WS_LIST); unsigned short* OFFS = (unsigned short*)(a.ws + WS_OFFS);
    LAS unsigned char* KMhi = F.lds; LAS unsigned char* KMlo = F.lds + 8192;
    LAS int* cnt = (LAS int*)(F.lds + 16384);
    LAS int* off = cnt + 64;
    LAS int* cur = off + 72;
    LAS unsigned short* sorted = (LAS unsigned short*)(F.lds + 17408);
    const int lane = F.lane, fr = lane & 15, G = lane >> 4, w = F.wave, tid = F.tid;
    for (int unit = F.vcu; unit < BATCH * NBLK * MOBA_H; unit += F.G) {
        const int h = unit % MOBA_H, qb = (unit / MOBA_H) % NBLK, b = unit / (MOBA_H * NBLK);
        const size_t ub = (size_t)(b * MOBA_H + h) * NBLK + qb;
        __syncthreads();
        if (tid < 64) { cnt[tid] = 0; cur[tid] = 0; }
        { const int j = tid >> 3, c = tid & 7; const float* src = kmean + ((size_t)(b * MOBA_H + h) * NBLK + j) * HD + 8 * c;
          const f32x4 x0 = *(const f32x4*)src, x1 = *(const f32x4*)(src + 4);
          const float v[8] = {x0[0], x0[1], x0[2], x0[3], x1[0], x1[1], x1[2], x1[3]}; float hi[8], lo[8];
#pragma unroll
          for (int e = 0; e < 8; ++e) { hi[e] = (float)(_Float16)v[e]; lo[e] = v[e] - hi[e]; }
          u32x4 wh, wl; wh.x = pkh(hi[0], hi[1]); wh.y = pkh(hi[2], hi[3]); wh.z = pkh(hi[4], hi[5]); wh.w = pkh(hi[6], hi[7]);
          wl.x = pkh(lo[0], lo[1]); wl.y = pkh(lo[2], lo[3]); wl.z = pkh(lo[4], lo[5]); wl.w = pkh(lo[6], lo[7]);
          *(LAS u32x4*)(KMhi + j * 128 + ((c ^ (j & 7)) << 4)) = wh; *(LAS u32x4*)(KMlo + j * 128 + ((c ^ (j & 7)) << 4)) = wl; }
        __syncthreads();
        const int nsel = qb < 3 ? qb : 3, njt = qb > 0 ? ((qb - 1) >> 4) + 1 : 0;
        int isel[2] = {0, 0};
#pragma unroll
        for (int rep = 0; rep < 2; ++rep) {
            const int qi = 16 * (w + 8 * rep) + fr;
            const f16_t* qp = P + (size_t)(b * SEQ + qb * MOBA_BLK + qi) * NB + h * HD + 8 * G;
            const h16x8 q0 = *(const h16x8*)qp, q1 = *(const h16x8*)(qp + 32);
            unsigned t0 = 0u, t1 = 0u, t2 = 0u;
            const int kof0 = fr * 128 + (((0 + G) ^ (fr & 7)) << 4), kof1 = fr * 128 + (((4 + G) ^ (fr & 7)) << 4);
            for (int jt = 0; jt < njt; ++jt) {
                f32x4 acc = {0.f, 0.f, 0.f, 0.f};
                acc = __builtin_amdgcn_mfma_f32_16x16x32_f16(*(LAS const h16x8*)(KMhi + jt * 2048 + kof0), q0, acc, 0, 0, 0);
                acc = __builtin_amdgcn_mfma_f32_16x16x32_f16(*(LAS const h16x8*)(KMhi + jt * 2048 + kof1), q1, acc, 0, 0, 0);
                acc = __builtin_amdgcn_mfma_f32_16x16x32_f16(*(LAS const h16x8*)(KMlo + jt * 2048 + kof0), q0, acc, 0, 0, 0);
                acc = __builtin_amdgcn_mfma_f32_16x16x32_f16(*(LAS const h16x8*)(KMlo + jt * 2048 + kof1), q1, acc, 0, 0, 0);
#pragma unroll
                for (int e = 0; e < 4; ++e) { const int j = 16 * jt + 4 * G + e; const unsigned k = (j < qb) ? sel_key(acc[e], j) : 0u; SEL_INSERT(k); }
            }
#pragma unroll
            for (int x = 16; x <= 32; x <<= 1) {
                const unsigned p0 = (unsigned)__shfl_xor((int)t0, x), p1 = (unsigned)__shfl_xor((int)t1, x), p2 = (unsigned)__shfl_xor((int)t2, x);
                SEL_INSERT(p0); SEL_INSERT(p1); SEL_INSERT(p2);
            }
            const unsigned tk = (G == 0) ? t0 : (G == 1) ? t1 : t2;
            isel[rep] = 63 - (int)(tk & 63u);
            if (G < nsel) __hip_atomic_fetch_add(cnt + isel[rep], 1, __ATOMIC_RELAXED, __HIP_MEMORY_SCOPE_WORKGROUP);
        }
        __syncthreads();
        if (w == 0) { const int c = cnt[lane]; int s = c;
#pragma unroll
            for (int o = 1; o < 64; o <<= 1) { const int t = __shfl_up(s, o); if (lane >= o) s += t; }
            off[lane] = s - c; if (lane == 63) off[64] = s; }
        __syncthreads();
#pragma unroll
        for (int rep = 0; rep < 2; ++rep) if (G < nsel) {
            const int qi = 16 * (w + 8 * rep) + fr;
            const int pos = __hip_atomic_fetch_add(cur + isel[rep], 1, __ATOMIC_RELAXED, __HIP_MEMORY_SCOPE_WORKGROUP);
            sorted[off[isel[rep]] + pos] = (unsigned short)((qi << 2) | G); }
        __syncthreads();
        const int total = off[64];
        for (int k = tid; k < total; k += 512) LIST[ub * LIST_CAP + k] = sorted[k];
        if (tid < 65) OFFS[ub * OFFS_LD + tid] = (unsigned short)off[tid];
    }
}
#undef SEL_INSERT

constexpr int SP_PART = 512;
struct SpItem { int n, lq, j; unsigned short raw; };
__device__ __forceinline__ void sp_prefetch(int it, int bh, LAS const int* IP, LAS const int* NJ, LAS const unsigned short* cum, LAS const unsigned short* offs, const unsigned short* LIST,
                                            const f16_t* P, LAS unsigned char* img, int wave, int lane, int tid, SpItem& o) {
    int l2 = 0, h2 = 64; while (h2 - l2 > 1) { const int mid = (l2 + h2) >> 1; if (IP[mid] <= it) l2 = mid; else h2 = mid; }
    const int j = l2, part = it - IP[l2], b = bh / MOBA_H, h = bh % MOBA_H;
    int n = NJ[j] - part * SP_PART; if (n > SP_PART) n = SP_PART; o.n = n; o.j = j;
    const f16_t* kb = P + (size_t)(b * SEQ + j * MOBA_BLK) * NB + MIXW + h * HD;
    dma_kv_imgs(img, img + 32768, kb, kb + MIXW, wave, lane);
    const int ei = (lane < 32) ? 32 * wave + lane : 256 + 32 * wave + (lane - 32);
    if (ei < n) { const int e = part * SP_PART + ei; const LAS unsigned short* cj = cum + j; int lq = 0, hq = 64;
        while (hq - lq > 1) { const int mid = (lq + hq) >> 1; if ((int)cj[mid * NBLK] <= e) lq = mid; else hq = mid; }
        o.lq = lq;
        o.raw = LIST[((size_t)bh * NBLK + lq) * LIST_CAP + offs[lq * OFFS_LD + j] + (e - (int)cj[lq * NBLK])]; }
}
template <bool ENGINE, int ESTEPS>
__device__ __forceinline__ void moba_sparse(const Frame& F, const Args& a, int rep) {
    const f16_t* P = (const f16_t*)(a.ws + WS_P16);
    const unsigned short* LIST = (const unsigned short*)(a.ws + WS_LIST); const unsigned short* OFFS = (const unsigned short*)(a.ws + WS_OFFS);
    f16_t* PO = (f16_t*)(a.ws + WS_PO); float* PL = (float*)(a.ws + WS_PL);
    const int ncl = F.G / 8; if (ncl == 0) return;
    const int xg = F.vcu / ncl; if (xg >= 8) return;
    LAS unsigned short* offs = (LAS unsigned short*)(F.lds + 131072);
    LAS unsigned short* cum = (LAS unsigned short*)(F.lds + 139776);
    LAS int* NJ = (LAS int*)(F.lds + 147968);
    LAS int* IP = NJ + 64;
    LAS unsigned* plist = (LAS unsigned*)(F.lds + 148992);
    LAS int* itq = (LAS int*)(F.lds + 151040);
    const int lane = F.lane, fr = lane & 15, G = lane >> 4, w = F.wave, tid = F.tid;
    const float maxgk = wave_max(fabsf(a.in[12][lane]));
    for (int bl = 0; bl < 3; ++bl) {
        const int bh = xg + 8 * bl, b = bh / MOBA_H, h = bh % MOBA_H;
        unsigned* qctr = (unsigned*)(F.ctl + CW_QUEUE + 64 * (xg * 3 + bl) + 2048 * rep);
        __syncthreads();
        for (int i = tid; i < NBLK * OFFS_LD / 2; i += 512) ((LAS unsigned*)offs)[i] = ((const unsigned*)(OFFS + (size_t)bh * NBLK * OFFS_LD))[i];
        if (tid == 0) { itq[0] = (int)__hip_atomic_fetch_add(qctr, 1u, RLX_AGENT); itq[1] = (int)__hip_atomic_fetch_add(qctr, 1u, RLX_AGENT); }
        __syncthreads();
        if (tid < 64) { const int j = tid; int acc = 0;
            for (int qb = 0; qb < NBLK; ++qb) { cum[qb * NBLK + j] = (unsigned short)acc;
                if (qb > j && j < NBLK - 1) acc += (int)offs[qb * OFFS_LD + j + 1] - (int)offs[qb * OFFS_LD + j]; }
            NJ[j] = acc;
            const int c = (acc + SP_PART - 1) / SP_PART; int s = c;
#pragma unroll
            for (int o = 1; o < 64; o <<= 1) { const int t = __shfl_up(s, o); if (lane >= o) s += t; }
            IP[j] = s - c; if (j == 63) IP[64] = s; }
        __syncthreads();
        const int TI = IP[64];
        int it_cur = itq[0], it_nxt = itq[1], cb = 0;
        SpItem pf; pf.n = 0; pf.lq = 0; pf.j = 0; pf.raw = 0;
        if (it_cur < TI) sp_prefetch(it_cur, bh, IP, NJ, cum, offs, LIST, P, F.lds, w, lane, tid, pf);
        for (int iter = 0;; ++iter) {
            VM_WAIT();
            const int coming = (iter == 0) ? it_cur : it_nxt; const bool have = coming < TI;
            const int n = have ? pf.n : 0;
            const int ei = (lane < 32) ? 32 * w + lane : 256 + 32 * w + (lane - 32);
            unsigned ment = 0u; if (ei < n) ment = ((unsigned)(pf.lq * MOBA_BLK + (int)(pf.raw >> 2)) << 2) | (unsigned)(pf.raw & 3);
            const int nw0 = n - 32 * w, nw1 = n - 256 - 32 * w;
            unsigned ea = 0u, eb = 0u; h16x8 ra0, ra1, rb0, rb1;
            if (nw0 > 0) { ea = (unsigned)__shfl((int)ment, fr < nw0 ? fr : nw0 - 1); eb = (unsigned)__shfl((int)ment, 16 + fr < nw0 ? 16 + fr : nw0 - 1);
                const f16_t* pa = P + (size_t)(b * SEQ + (int)(ea >> 2)) * NB + h * HD + 8 * G; const f16_t* pb = P + (size_t)(b * SEQ + (int)(eb >> 2)) * NB + h * HD + 8 * G;
                ra0 = *(const h16x8*)pa; ra1 = *(const h16x8*)(pa + 32); rb0 = *(const h16x8*)pb; rb1 = *(const h16x8*)(pb + 32); }
            __syncthreads();
            if (iter > 0) { it_cur = it_nxt; it_nxt = itq[0]; }
            if (it_cur >= TI) break;
            LAS const unsigned char* Kimg = F.lds + cb * 65536; LAS const unsigned char* Vimg = Kimg + 32768;
            unsigned nn = 0u; if (tid == 0) nn = __hip_atomic_fetch_add(qctr, 1u, RLX_AGENT);
            const int npairs = nw0 <= 0 ? 0 : (nw1 > 0 ? 2 : 1); bool done_pf = false;
            for (int k = 0; k < npairs; ++k) {
                const int nwk = k ? nw1 : nw0;
                const bool va = fr < nwk, vb = 16 + fr < nwk; const unsigned cea = ea, ceb = eb;
                const int ta = (int)(cea >> 2), tb = (int)(ceb >> 2);
                h16x8 qa0, qa1, qb0, qb1; float mba, mbb;
                moba_finish_q(ra0, ra1, maxgk, qa0, qa1, mba); moba_finish_q(rb0, rb1, maxgk, qb0, qb1, mbb);
                if (k + 1 < npairs) {
                    ea = (unsigned)__shfl((int)ment, 32 + (fr < nw1 ? fr : nw1 - 1)); eb = (unsigned)__shfl((int)ment, 32 + (16 + fr < nw1 ? 16 + fr : nw1 - 1));
                    const f16_t* pa = P + (size_t)(b * SEQ + (int)(ea >> 2)) * NB + h * HD + 8 * G; const f16_t* pb = P + (size_t)(b * SEQ + (int)(eb >> 2)) * NB + h * HD + 8 * G;
                    ra0 = *(const h16x8*)pa; ra1 = *(const h16x8*)(pa + 32); rb0 = *(const h16x8*)pb; rb1 = *(const h16x8*)(pb + 32); }
                else { done_pf = true; if (it_nxt < TI) sp_prefetch(it_nxt, bh, IP, NJ, cum, offs, LIST, P, F.lds + (cb ^ 1) * 65536, w, lane, tid, pf); }
                f32x4 oa[4], ob[4]; float lsa = 0.f, lsb = 0.f;
#pragma unroll
                for (int dt = 0; dt < 4; ++dt) { oa[dt] = (f32x4){0.f, 0.f, 0.f, 0.f}; ob[dt] = oa[dt]; }
                if (ENGINE || ESTEPS > 0) attn_tile2<false, true>(Kimg, Vimg, Kimg, Vimg, ENGINE ? MOBA_BLK / 32 : ESTEPS, qa0, qa1, mba, 0, qb0, qb1, mbb, 0, oa, ob, lsa, lsb, lane); else { lsa = mba; lsb = mbb; oa[0][0] = (float)qa0[0] + (float)qa1[1]; ob[0][0] = (float)qb0[0] + (float)qb1[1]; }
                const float ila = 1.0f / lsa, ilb = 1.0f / lsb;
                if (!ENGINE) { asm volatile("" :: "v"(lsa), "v"(lsb), "v"(oa[0][0]), "v"(ob[0][0])); }
                { const size_t pia = ((size_t)bh * SEQ + ta) * 3 + (cea & 3u), pib = ((size_t)bh * SEQ + tb) * 3 + (ceb & 3u);
                  u32x4 sa[2], sb[2];
#pragma unroll
                  for (int pr = 0; pr < 2; ++pr) { const int dt0 = 2 * pr; u32x2 x, y;
                      x.x = pkh(oa[dt0][0] * ila, oa[dt0][1] * ila); x.y = pkh(oa[dt0][2] * ila, oa[dt0][3] * ila); y.x = pkh(oa[dt0 + 1][0] * ila, oa[dt0 + 1][1] * ila); y.y = pkh(oa[dt0 + 1][2] * ila, oa[dt0 + 1][3] * ila); sa[pr] = pair16(x, y);
                      x.x = pkh(ob[dt0][0] * ilb, ob[dt0][1] * ilb); x.y = pkh(ob[dt0][2] * ilb, ob[dt0][3] * ilb); y.x = pkh(ob[dt0 + 1][0] * ilb, ob[dt0 + 1][1] * ilb); y.y = pkh(ob[dt0 + 1][2] * ilb, ob[dt0 + 1][3] * ilb); sb[pr] = pair16(x, y); }
                  if (va && ENGINE) { *(u32x4*)(PO + pia * HD + pair16_dim(G, 0)) = sa[0]; *(u32x4*)(PO + pia * HD + pair16_dim(G, 2)) = sa[1]; if (G == 0) PL[pia] = lsa; }
                  if (vb && ENGINE) { *(u32x4*)(PO + pib * HD + pair16_dim(G, 0)) = sb[0]; *(u32x4*)(PO + pib * HD + pair16_dim(G, 2)) = sb[1]; if (G == 0) PL[pib] = lsb; } }
            }
            if (!done_pf && it_nxt < TI) sp_prefetch(it_nxt, bh, IP, NJ, cum, offs, LIST, P, F.lds + (cb ^ 1) * 65536, w, lane, tid, pf);
            if (tid == 0) itq[0] = (int)nn;
            cb ^= 1;
        }
    }
}

template <bool PR_ENG, bool PR_PART, bool PR_ST>
__device__ __forceinline__ void moba_own(const Frame& F, const Args& a) {
    const f16_t* P = (const f16_t*)(a.ws + WS_P16); f16_t* Y = (f16_t*)(a.ws + WS_Y16);
    const f16_t* PO = (const f16_t*)(a.ws + WS_PO); const float* PL = (const float*)(a.ws + WS_PL);
    const int lane = F.lane, fr = lane & 15, G = lane >> 4, w = F.wave;
    const float maxgk = wave_max(fabsf(a.in[12][lane]));
    for (int up = F.vcu; up < BATCH * MOBA_H * NBLK / 2; up += F.G) {
        const int bh = up / (NBLK / 2), b = bh / MOBA_H, h = bh % MOBA_H, qb0 = 2 * (up % (NBLK / 2));
        __syncthreads();
#pragma unroll
        for (int k = 0; k < 2; ++k) { const f16_t* kb = P + (size_t)(b * SEQ + (qb0 + k) * MOBA_BLK) * NB + MIXW + h * HD;
            dma_kv_imgs(F.lds + k * 65536, F.lds + k * 65536 + 32768, kb, kb + MIXW, w, lane); }
        const int dt0 = w, dt1 = 7 - w;
        const int tq[2][2] = {{qb0 * MOBA_BLK + 32 * dt0 + fr, qb0 * MOBA_BLK + 32 * dt0 + 16 + fr}, {(qb0 + 1) * MOBA_BLK + 32 * dt1 + fr, (qb0 + 1) * MOBA_BLK + 32 * dt1 + 16 + fr}};
        VM_WAIT();
        __syncthreads();
#pragma unroll
        for (int k = 0; k < 2; ++k) {
            const int qb = qb0 + k, nsel = qb < 3 ? qb : 3, dti = k ? dt1 : dt0;
            const int ta = tq[k][0], tb = tq[k][1];
            h16x8 q0[2][2], q1[2][2]; float mb[2][2];
#pragma unroll
            for (int t = 0; t < 2; ++t) moba_load_q(P + (size_t)(b * SEQ + tq[k][t]) * NB + h * HD, G, maxgk, q0[k][t], q1[k][t], mb[k][t]);
            f32x4 oa[4], ob[4]; float lsa = 0.f, lsb = 0.f;
#pragma unroll
            for (int dt = 0; dt < 4; ++dt) { oa[dt] = (f32x4){0.f, 0.f, 0.f, 0.f}; ob[dt] = oa[dt]; }
            LAS const unsigned char* Ki = F.lds + k * 65536;
            if (PR_ENG) attn_tile2<true, true>(Ki, Ki + 32768, Ki, Ki + 32768, dti + 1, q0[k][0], q1[k][0], mb[k][0], 32 * dti + fr, q0[k][1], q1[k][1], mb[k][1], 32 * dti + 16 + fr, oa, ob, lsa, lsb, lane); else { lsa = mb[k][0] + (float)q0[k][0][0] + (float)q1[k][0][1]; lsb = mb[k][1] + (float)q0[k][1][0] + (float)q1[k][1][1]; }
            float pl[2][3]; u32x4 pw[2][3][2];
#pragma unroll
            for (int slot = 0; slot < 3; ++slot) if (PR_PART && slot < nsel) {
                const size_t pia = ((size_t)bh * SEQ + ta) * 3 + slot, pib = ((size_t)bh * SEQ + tb) * 3 + slot;
                pl[0][slot] = __builtin_nontemporal_load(PL + pia); pl[1][slot] = __builtin_nontemporal_load(PL + pib);
#pragma unroll
                for (int pr = 0; pr < 2; ++pr) { pw[0][slot][pr] = __builtin_nontemporal_load((const u32x4*)(PO + pia * HD + pair16_dim(G, 2 * pr))); pw[1][slot][pr] = __builtin_nontemporal_load((const u32x4*)(PO + pib * HD + pair16_dim(G, 2 * pr))); } }
#pragma unroll
            for (int slot = 0; slot < 3; ++slot) if (PR_PART && slot < nsel) {
#pragma unroll
                for (int pr = 0; pr < 2; ++pr) { u32x2 xa, ya, xb, yb; unpair16(pw[0][slot][pr], xa, ya); unpair16(pw[1][slot][pr], xb, yb);
                    const h16x4 va0 = __builtin_bit_cast(h16x4, xa), va1 = __builtin_bit_cast(h16x4, ya), vb0 = __builtin_bit_cast(h16x4, xb), vb1 = __builtin_bit_cast(h16x4, yb);
#pragma unroll
                    for (int e = 0; e < 4; ++e) { oa[2 * pr][e] += pl[0][slot] * (float)va0[e]; oa[2 * pr + 1][e] += pl[0][slot] * (float)va1[e]; ob[2 * pr][e] += pl[1][slot] * (float)vb0[e]; ob[2 * pr + 1][e] += pl[1][slot] * (float)vb1[e]; } }
                lsa += pl[0][slot]; lsb += pl[1][slot]; }
            const float ila = 1.0f / lsa, ilb = 1.0f / lsb;
            if (PR_ST) { store_o8((unsigned char*)Y + (size_t)(b * SEQ + ta) * DM + h * HD, oa, ila, G); store_o8((unsigned char*)Y + (size_t)(b * SEQ + tb) * DM + h * HD, ob, ilb, G); }
            else asm volatile("" :: "v"(oa[0][0] * ila), "v"(ob[0][0] * ilb));
        }
    }
}
__device__ __forceinline__ void xattn_b(const Frame& F, const Args& a) {
    const f16_t* P = (const f16_t*)(a.ws + WS_P16); f16_t* Y = (f16_t*)(a.ws + WS_Y16);
    __syncthreads();
    for (int chunk = F.vcu; chunk < M / CHUNK; chunk += F.G) xattn_chunk<true>(F, a, chunk, P, NB, 3 * MIXW, a.in[16] + HD, Y);
}

__device__ __forceinline__ void ffn_fixup(const Frame& F, const float* bnd_g, const float* cw, const float* cb, f16_t* U) {
    constexpr int HALF = pg8::HALF, NNU = FF2 / 256, TOTAL = (M / 256) * NNU * HALF, NIT = 3;
    const int stride = F.G * (NWAVES * 64);
    for (int base = F.vcu * (NWAVES * 64) + F.tid; base < TOTAL; base += NIT * stride) {
    float x[NIT][2][4], wv[NIT][2][4];
#pragma unroll
    for (int k = 0; k < NIT; ++k) {
        const int idx = base + k * stride, id2 = idx < TOTAL ? idx : 0;
        const int j = id2 & (HALF - 1), unit = id2 >> 7, pm = unit / NNU, pn = unit % NNU;
        const float* own = bnd_g + (size_t)unit * 1024; const bool first = (pm % (SEQ / 256)) == 0; const float* prv = first ? own : own - (size_t)NNU * 1024;
#pragma unroll
        for (int part = 0; part < 2; ++part) {
            const int c = part * HALF + j, gc = part * FF + pn * HALF + j;
            const float a2 = prv[2 * 256 + c], a1 = prv[3 * 256 + c];
            x[k][part][0] = first ? 0.f : a2; x[k][part][1] = first ? 0.f : a1; x[k][part][2] = own[c]; x[k][part][3] = own[256 + c];
            wv[k][part][0] = cw[gc]; wv[k][part][1] = cw[FF2 + gc]; wv[k][part][2] = cw[2 * FF2 + gc]; wv[k][part][3] = cb[gc];
        }
    }
#pragma unroll
    for (int k = 0; k < NIT; ++k) {
        const int idx = base + k * stride; if (idx >= TOTAL) break;
        const int j = idx & (HALF - 1), unit = idx >> 7, pm = unit / NNU, pn = unit % NNU;
        float h0[2], h1[2];
#pragma unroll
        for (int part = 0; part < 2; ++part) {
            h0[part] = fmaf(wv[k][part][0], x[k][part][0], fmaf(wv[k][part][1], x[k][part][1], fmaf(wv[k][part][2], x[k][part][2], wv[k][part][3])));
            h1[part] = fmaf(wv[k][part][0], x[k][part][1], fmaf(wv[k][part][1], x[k][part][2], fmaf(wv[k][part][2], x[k][part][3], wv[k][part][3])));
        }
        f16_t* up = U + (size_t)(pm * 256) * FF + pn * HALF + j;
        up[0] = f2h(gelu_tanh(h0[0]) * h0[1]); up[FF] = f2h(gelu_tanh(h1[0]) * h1[1]);
    }
    }
}

__global__ void __launch_bounds__(NWAVES * 64, 2) fwd_kernel(Args args) {
    extern __shared__ __attribute__((aligned(16))) unsigned char lds_raw[];
    Frame F;
    F.lds = (LAS unsigned char*)lds_raw;
    F.MISC = (volatile LAS unsigned*)(F.lds + MISC_OFF);
    F.tid = threadIdx.x; F.lane = F.tid & 63; F.wave = __builtin_amdgcn_readfirstlane(F.tid >> 6);
    F.G = gridDim.x; { const int bx = blockIdx.x; F.vcu = (F.G % 8 == 0) ? (bx % 8) * (F.G / 8) + bx / 8 : bx; }
    unsigned char* ws = args.ws;
    F.ctl = (gu32*)(ws + WS_CTL);
    for (int u = F.tid; u < 64; u += NWAVES * 64) ((LAS unsigned*)(F.lds + MISC_OFF))[u] = 0u;
    __syncthreads();
    const int lo = args.ph_lo, hi = args.ph_hi;
    XcdBarrier bar; bar.bar = (unsigned*)(F.ctl + CW_BAR); bar.x = 0; bar.st = nullptr;
    if (hi - lo > 1) bar = xcd_barrier_post((unsigned*)(F.ctl + CW_BAR), F.MISC + 8);
#define IN(k) (lo <= (k) && (k) < hi)
#ifndef PROBE_BARX
#define PROBE_BARX 0
#endif
#define SEAM(k) do { if (IN(k) && IN((k) + 1)) { xcd_barrier(bar); if (PROBE_BARX && (k) == 2) { for (int r_ = 0; r_ < 10; ++r_) xcd_barrier(bar); } } } while (0)
    LAS unsigned char* ring = F.lds; LAS unsigned char* xl = F.lds + XCH_OFF;
    f16_t* A16 = (f16_t*)(ws + WS_A16); f16_t* Y16 = (f16_t*)(ws + WS_Y16); f16_t* P16 = (f16_t*)(ws + WS_P16);
    float* SS0 = (float*)(F.ctl + CW_SS0); float* SSV = (float*)(F.ctl + CW_SSV); float* SS1 = (float*)(F.ctl + CW_SS1); float* SS2 = (float*)(F.ctl + CW_SS2); float* SS3 = (float*)(F.ctl + CW_SS3);
    float* KMEAN = (float*)(F.ctl + CW_KMEAN);
    const int c = (int)blockIdx.x;

#ifndef PROBE_DUP
#define PROBE_DUP -1
#endif
#define RUNS(k) for (int rep = 0; rep < (((k) == PROBE_DUP) ? 2 : 1); ++rep)
    if (IN(0)) { RUNS(0) p0_prologue(F, args); } SEAM(0);
    if (IN(1)) { { pg8::Gemm g{(const f16_t*)(ws + WS_MEM16), (const f16_t*)(ws + WS_WKV), DM}; pg8::Order S; S.init(2, 2, F.G, (c + 4) % F.G, 0);
        pg8::EpiKV E{(f16_t*)(ws + WS_KM16), (f16_t*)(ws + WS_VM16), (const float*)(F.ctl + CW_SSM), args.in[15]}; pg8::gemm_phase<pg8::EpiKV, true>(ring, xl, g, S, E); }
      RUNS(1) { pg8::Gemm g{A16, (const f16_t*)(ws + WS_WINA), DM}; pg8::Order S; S.init(M / 256, NA / 256, F.G, c, 0);
        pg8::EpiInA E{P16, SS0, SSV, rep > 0}; pg8::gemm_phase<pg8::EpiInA, true>(ring, xl, g, S, E); }
      { int ilo = ((M / 256) * (NA / 256)) % F.G, ihi = F.G - 4; if (ihi - ilo < 8) { ilo = 0; ihi = F.G; }
        if (c >= ilo && c < ihi) { __syncthreads(); p0_late_weights(F, args, (c - ilo) * NWAVES + F.wave, (ihi - ilo) * NWAVES); __syncthreads(); } } } SEAM(1);
#ifndef PROBE_P2
#define PROBE_P2 0
#endif
    if (IN(2)) { mixer_a<true, true>(F, args); if (PROBE_P2 == 1) mixer_a<true, false>(F, args); if (PROBE_P2 == 2) mixer_a<false, true>(F, args); } SEAM(2);
    if (IN(3)) { RUNS(3) { pg8::Gemm g{Y16, (const f16_t*)(ws + WS_WOUTA), DM}; pg8::Order S; S.init(M / 256, DM / 256, F.G, c, 0);
        pg8::EpiRes E{A16, nullptr, SS1, rep > 0, nullptr, 1.0f}; pg8::gemm_phase<pg8::EpiRes, true>(ring, xl, g, S, E); } } SEAM(3);
    float* BNDG = (float*)(ws + WS_Y16);
    if (IN(4)) { RUNS(4) { pg8::Gemm g{A16, (const f16_t*)(ws + WS_WUP0), DM}; pg8::Order S; S.init(M / 256, FF2 / 256, F.G, c, 0);
        pg8::EpiUp E{P16, SS1, args.in[18], args.in[19], BNDG}; pg8::gemm_phase<pg8::EpiUp, true>(ring, xl, g, S, E); }
      if (hi - lo > 1) xcd_barrier(bar);
      ffn_fixup(F, BNDG, args.in[18], args.in[19], P16);
#ifdef PROBE_NULL4
      { pg8::Gemm g{A16, (const f16_t*)(ws + WS_WUP0), DM}; pg8::Order S; S.init(M / 256, FF2 / 256, F.G, c, 0); pg8::EpiNull E{}; pg8::gemm_phase<pg8::EpiNull, true>(ring, xl, g, S, E); }
#endif
    } SEAM(4);
    if (IN(5)) { RUNS(5) { pg8::Gemm g{P16, (const f16_t*)(ws + WS_WDN0), FF}; pg8::Order S; S.init(M / 256, DM / 256, F.G, c, 0);
        pg8::EpiRes E{A16, nullptr, SS2, rep > 0, ws + WS_PO  , 1.0f}; pg8::gemm_phase<pg8::EpiRes, true>(ring, xl, g, S, E); } } SEAM(5);
    if (IN(6)) { RUNS(6) { pg8::Gemm g{(const f16_t*)(ws + WS_PO), (const f16_t*)(ws + WS_WINB), DM / 2};   pg8::Order S; S.init(M / 256, NB / 256, F.G, c, 0);
        pg8::EpiInB E{P16, SS2, args.in[11], args.in[12], KMEAN, rep > 0, 1.0f / (F8_SA * F8_SW)}; pg8::gemm_phase<pg8::EpiInB, true, true>(ring, xl, g, S, E); } } SEAM(6);
#ifndef PROBE_P7
#define PROBE_P7 0
#endif
    if (IN(7)) { moba_select(F, args); xattn_b(F, args); if (PROBE_P7 == 1) moba_select(F, args); if (PROBE_P7 == 2) xattn_b(F, args); } SEAM(7);
#ifndef PROBE_SPARSE_NOENG
#define PROBE_SPARSE_NOENG 0
#endif
#ifndef PROBE_ESTEPS
#define PROBE_ESTEPS 0
#endif
    if (IN(8)) { moba_sparse<true, 8>(F, args, 0); if (PROBE_SPARSE_NOENG) moba_sparse<false, PROBE_ESTEPS>(F, args, 1); else if (PROBE_DUP == 8) moba_sparse<true, 8>(F, args, 1); } SEAM(8);
#ifndef PROBE_OWN
#define PROBE_OWN 0
#endif
    if (IN(9)) { moba_own<true, true, true>(F, args); if (PROBE_OWN == 1) moba_own<true, true, false>(F, args); if (PROBE_OWN == 2) moba_own<false, true, false>(F, args); if (PROBE_OWN == 3) moba_own<true, false, false>(F, args); if (PROBE_OWN == 4) moba_own<false, false, false>(F, args); } SEAM(9);
    if (IN(10)) { RUNS(10) { pg8::Gemm g{Y16, (const f16_t*)(ws + WS_WOUTB), DM / 2};   pg8::Order S; S.init(M / 256, DM / 256, F.G, c, 0);
        pg8::EpiRes E{A16, nullptr, SS3, rep > 0, nullptr, 1.0f / (F8_SY * F8_SW)}; pg8::gemm_phase<pg8::EpiRes, true, true>(ring, xl, g, S, E); } } SEAM(10);
    if (IN(11)) { RUNS(11) { pg8::Gemm g{A16, (const f16_t*)(ws + WS_WUP1), DM}; pg8::Order S; S.init(M / 256, FF2 / 256, F.G, c, 0);
        pg8::EpiUp E{P16, SS3, args.in[18] + 3 * FF2, args.in[19] + FF2, BNDG}; pg8::gemm_phase<pg8::EpiUp, true>(ring, xl, g, S, E); }
      if (hi - lo > 1) xcd_barrier(bar);
      ffn_fixup(F, BNDG, args.in[18] + 3 * FF2, args.in[19] + FF2, P16); } SEAM(11);
    if (IN(12)) { RUNS(12) { pg8::Gemm g{P16, (const f16_t*)(ws + WS_WDN1), FF}; pg8::Order S; S.init(M / 256, DM / 256, F.G, c, 0);
        pg8::EpiRes E{A16, args.out, nullptr, rep > 0, nullptr, 1.0f}; pg8::gemm_phase<pg8::EpiRes, true>(ring, xl, g, S, E); } }
#undef IN
#undef SEAM
}

extern "C" void kernel_launch(void* const* d_in, const int* in_sizes, int n_in, void* d_out, int out_size, void* d_ws, size_t ws_size, hipStream_t stream) {
    static int grid = 0;
    if (grid == 0) {
        if (n_in != 21 || in_sizes[0] != M * DM || out_size != M * DM || ws_size < WS_END) { fprintf(stderr, "kernel_launch: unexpected shapes (n_in %d, in0 %d, out %d, ws %zu); nothing launched\n", n_in, n_in > 0 ? in_sizes[0] : -1, out_size, ws_size); grid = -1; return; }
        int dev = 0, cus = 0;
        if (hipGetDevice(&dev) != hipSuccess || hipDeviceGetAttribute(&cus, hipDeviceAttributeMultiprocessorCount, dev) != hipSuccess) { grid = -1; return; }
        if (hipFuncSetAttribute((const void*)fwd_kernel, hipFuncAttributeMaxDynamicSharedMemorySize, LDS_BYTES) != hipSuccess) { fprintf(stderr, "kernel_launch: hipFuncSetAttribute failed\n"); grid = -1; return; }
        (void)hipGetLastError();
        grid = cus;
    }
    if (grid < 0) return;
    if (hipMemsetAsync((char*)d_ws + WS_CTL, 0, CTL_BYTES, stream) != hipSuccess) return;
    Args a{};
    for (int i = 0; i < 21; ++i) a.in[i] = (const float*)d_in[i];
    a.out = (float*)d_out; a.ws = (unsigned char*)d_ws;
#if MK_ONE_LAUNCH
    a.ph_lo = 0; a.ph_hi = 13;
    hipLaunchKernelGGL(fwd_kernel, dim3(grid), dim3(NWAVES * 64), LDS_BYTES, stream, a);
#else
    for (int p = 0; p < 13; ++p) { a.ph_lo = p; a.ph_hi = p + 1; hipLaunchKernelGGL(fwd_kernel, dim3(grid), dim3(NWAVES * 64), LDS_BYTES, stream, a); }
#endif
}
```
